# Optimizing an MI355X kernel written in HIP

```python
import jax, jax.numpy as jnp
from jax import lax
import numpy as np

D_MODEL = 2048
BATCH = 16
SEQ = 2048
DEPTH = 4
DEC_BATCH = 4
DEC_SEQ = 2048
PAST_LEN = 128

N_MIXERS = 2
N_CONV_LAYERS = (DEPTH + 1) // 2
N_ATTN_LAYERS = DEPTH // 2
CONV_WIDTH = 3
HEAD_DIM = 128
N_HEADS = D_MODEL // HEAD_DIM
N_KV_HEADS = 4
GROUP = N_HEADS // N_KV_HEADS
WINDOW = 128
BLOCK = 128
NEIGH = WINDOW // BLOCK
BAND = (2 * NEIGH + 1) * BLOCK
ROPE_THETA = 10000.0
D_FF = ((8 * D_MODEL + 3 * 256 - 1) // (3 * 256)) * 256
EPS = 1e-6
NEG_INF = -1e30

kernel_name = "hybrid_shortconv_swa_sink_encoder"


def rmsnorm(x, g):
    xf = x.astype(jnp.float32)
    r = lax.rsqrt(jnp.mean(xf * xf, axis=-1, keepdims=True) + EPS)
    return (xf * r).astype(x.dtype) * g


def short_conv_mixer(x, w_in, w_conv, w_out):
    bch = x @ w_in
    b, c, h = jnp.split(bch, 3, axis=-1)
    u = c * h
    up = jnp.pad(u, ((0, 0), (CONV_WIDTH // 2, CONV_WIDTH // 2), (0, 0)))
    S = x.shape[1]
    v = sum(w_conv[t] * up[:, t:t + S] for t in range(CONV_WIDTH))
    return (b * v) @ w_out


def rope(x, cos, sin):
    x1, x2 = jnp.split(x, 2, axis=-1)
    return jnp.concatenate([x1 * cos - x2 * sin, x2 * cos + x1 * sin], axis=-1)


def band_mask(S):
    nb = S // BLOCK
    qpos = np.arange(nb)[:, None, None] * BLOCK + np.arange(BLOCK)[None, :, None]
    kpos = (np.arange(nb)[:, None, None] - NEIGH) * BLOCK + np.arange(BAND)[None, None, :]
    valid = (np.abs(qpos - kpos) <= WINDOW) & (kpos >= 0) & (kpos < S)
    return jnp.asarray(valid)


def windowed_gqa_sink(x, w_qkv, w_o, sink):
    B, S, _ = x.shape
    nb = S // BLOCK
    qkv = x @ w_qkv
    q, k, v = jnp.split(qkv, [N_HEADS * HEAD_DIM, (N_HEADS + N_KV_HEADS) * HEAD_DIM], axis=-1)
    q = q.reshape(B, S, N_HEADS, HEAD_DIM)
    k = k.reshape(B, S, N_KV_HEADS, HEAD_DIM)
    v = v.reshape(B, S, N_KV_HEADS, HEAD_DIM)

    inv_freq = 1.0 / (ROPE_THETA ** (jnp.arange(0, HEAD_DIM, 2, dtype=jnp.float32) / HEAD_DIM))
    ang = jnp.arange(S, dtype=jnp.float32)[:, None] * inv_freq[None, :]
    cos = jnp.cos(ang)[:, None, :].astype(x.dtype)
    sin = jnp.sin(ang)[:, None, :].astype(x.dtype)
    q = rope(q, cos, sin)
    k = rope(k, cos, sin)

    q = q.reshape(B, nb, BLOCK, N_KV_HEADS, GROUP, HEAD_DIM)
    pad = ((0, 0), (NEIGH * BLOCK, NEIGH * BLOCK), (0, 0), (0, 0))
    kp = jnp.pad(k, pad).reshape(B, nb + 2 * NEIGH, BLOCK, N_KV_HEADS, HEAD_DIM)
    vp = jnp.pad(v, pad).reshape(B, nb + 2 * NEIGH, BLOCK, N_KV_HEADS, HEAD_DIM)
    kb = jnp.concatenate([kp[:, t:t + nb] for t in range(2 * NEIGH + 1)], axis=2)
    vb = jnp.concatenate([vp[:, t:t + nb] for t in range(2 * NEIGH + 1)], axis=2)

    scale = HEAD_DIM ** -0.5
    s = jnp.einsum('bnqkgd,bnpkd->bnkgqp', q, kb).astype(jnp.float32) * scale
    mask = band_mask(S)[None, :, None, None]
    s = jnp.where(mask, s, NEG_INF)
    sink_b = jnp.broadcast_to(sink.astype(jnp.float32).reshape(N_KV_HEADS, GROUP)[None, None, :, :, None, None],
                              s.shape[:-1] + (1,))
    p = jax.nn.softmax(jnp.concatenate([s, sink_b], axis=-1), axis=-1)[..., :BAND].astype(v.dtype)
    o = jnp.einsum('bnkgqp,bnpkd->bnqkgd', p, vb).reshape(B, S, N_HEADS * HEAD_DIM)
    return o @ w_o


def swiglu(x, w_gate, w_up, w_down):
    return (jax.nn.silu(x @ w_gate) * (x @ w_up)) @ w_down


def trunk(x, conv_w_in, conv_w_dw, conv_w_out, attn_w_qkv, attn_w_o, attn_sink,
          ffn_w_gate, ffn_w_up, ffn_w_down, g_mix_pre, g_mix_post, g_ffn_pre, g_ffn_post):
    for i in range(DEPTH):
        h = rmsnorm(x, g_mix_pre[i])
        j = i // N_MIXERS
        if i % N_MIXERS == 0:
            h = short_conv_mixer(h, conv_w_in[j], conv_w_dw[j], conv_w_out[j])
        else:
            h = windowed_gqa_sink(h, attn_w_qkv[j], attn_w_o[j], attn_sink[j])
        x = x + rmsnorm(h, g_mix_post[i])
        h = swiglu(rmsnorm(x, g_ffn_pre[i]), ffn_w_gate[i], ffn_w_up[i], ffn_w_down[i])
        x = x + rmsnorm(h, g_ffn_post[i])
    return x


def setup_inputs(seed: int = 0) -> dict:
    key = jax.random.key(seed)
    ks = jax.random.split(key, 16)
    D, F = D_MODEL, D_FF
    QKV = (N_HEADS + 2 * N_KV_HEADS) * HEAD_DIM
    nrm = jax.random.normal
    f32 = jnp.float32
    return {
        "x_prompt": nrm(ks[0], (BATCH, SEQ, D), f32),
        "x_sample": nrm(ks[1], (DEC_BATCH, DEC_SEQ, D), f32),
        "conv_w_in": nrm(ks[2], (N_CONV_LAYERS, D, 3 * D), f32) * D ** -0.5,
        "conv_w_dw": nrm(ks[3], (N_CONV_LAYERS, CONV_WIDTH, D), f32) * CONV_WIDTH ** -0.5,
        "conv_w_out": nrm(ks[4], (N_CONV_LAYERS, D, D), f32) * D ** -0.5,
        "attn_w_qkv": nrm(ks[5], (N_ATTN_LAYERS, D, QKV), f32) * D ** -0.5,
        "attn_w_o": nrm(ks[6], (N_ATTN_LAYERS, N_HEADS * HEAD_DIM, D), f32) * (N_HEADS * HEAD_DIM) ** -0.5,
        "attn_sink": nrm(ks[7], (N_ATTN_LAYERS, N_HEADS), f32) * 0.5,
        "ffn_w_gate": nrm(ks[8], (DEPTH, D, F), f32) * D ** -0.5,
        "ffn_w_up": nrm(ks[9], (DEPTH, D, F), f32) * D ** -0.5,
        "ffn_w_down": nrm(ks[10], (DEPTH, F, D), f32) * F ** -0.5,
        "g_mix_pre": 1.0 + 0.05 * nrm(ks[11], (DEPTH, D), f32),
        "g_mix_post": 1.0 + 0.05 * nrm(ks[12], (DEPTH, D), f32),
        "g_ffn_pre": 1.0 + 0.05 * nrm(ks[13], (DEPTH, D), f32),
        "g_ffn_post": 1.0 + 0.05 * nrm(ks[14], (DEPTH, D), f32),
    }


def reference(x_prompt, x_sample, conv_w_in, conv_w_dw, conv_w_out, attn_w_qkv, attn_w_o,
              attn_sink, ffn_w_gate, ffn_w_up, ffn_w_down, g_mix_pre, g_mix_post, g_ffn_pre,
              g_ffn_post):
    y_prompt = trunk(x_prompt, conv_w_in, conv_w_dw, conv_w_out, attn_w_qkv, attn_w_o, attn_sink,
                     ffn_w_gate, ffn_w_up, ffn_w_down, g_mix_pre, g_mix_post, g_ffn_pre, g_ffn_post)
    y_sample = trunk(x_sample, conv_w_in, conv_w_dw, conv_w_out, attn_w_qkv, attn_w_o, attn_sink,
                     ffn_w_gate, ffn_w_up, ffn_w_down, g_mix_pre, g_mix_post, g_ffn_pre, g_ffn_post)
    return (y_prompt, y_sample)
```

```cpp
#include <hip/hip_runtime.h>
#include <cstdio>
#include <cstdint>
#ifndef PROBE_EPI2
#define PROBE_EPI2 0
#endif
namespace pg8 {
#define PG8_LAS __attribute__((address_space(3)))
typedef unsigned short bf16_t;
typedef short bf16x8 __attribute__((ext_vector_type(8)));
typedef float f32x4 __attribute__((ext_vector_type(4)));
typedef unsigned u32x4 __attribute__((ext_vector_type(4)));
constexpr int BM = 256, BK = 64, HALF = 128, HTB = HALF * BK * 2  , STAGE_BYTES = 8 * HTB, NXCD = 8, WGM = 8;

__host__ __device__ __forceinline__ int lds_byte(int r, int c) { const int st = (r >> 4) * 2 + (c >> 5), rr = r & 15, cc = c & 31, ob = rr * 64 + cc * 2; return st * 1024 + (ob ^ (((ob >> 9) & 1) << 5)); }
__host__ __device__ __forceinline__ void stage_rc(int b, int& R, int& C) { const int st = b / 1024, sb = b % 1024, swz = sb ^ (((sb >> 9) & 1) << 5); R = (st >> 1) * 16 + swz / 64; C = (st & 1) * 32 + (swz % 64) / 2; }
__host__ __device__ __forceinline__ int perm32(int rho) { const int n = rho >> 4, i = rho & 15; return 8 * (i >> 2) + 4 * n + (i & 3); }

struct Unit { int pm, pn; };
struct Gemm { const bf16_t* A; const bf16_t* Bt; int M, N, K; };

struct StaticOrder {
    int nM, nN, nwg, G, c, nx;
    __host__ __device__ void init(int M, int N, int G_, int c_, int nx_ = NXCD) { nM = M / BM; nN = N / BM; nwg = nM * nN; G = G_; c = c_; nx = nx_; }
    __host__ __device__ bool next(int i, Unit& u) const {
        const long L = (long)i * G + c; if (L >= nwg) return false;
        int wgid = (int)L; { const int q = nwg / nx, r = nwg % nx, xcd = wgid % nx, off = wgid / nx; wgid = (xcd < r ? xcd * (q + 1) : r * (q + 1) + (xcd - r) * q) + off; }
        const int nig = WGM * nN, gid = wgid / nig, fm = gid * WGM, gsz = (nM - fm) < WGM ? (nM - fm) : WGM;
        u.pm = fm + ((wgid % nig) % gsz); u.pn = (wgid % nig) / gsz; return true;
    }
    __device__ __forceinline__ void a_ready(const Unit&) const {}
    __device__ __forceinline__ void done(const Unit&) const {}
};
__device__ __forceinline__ unsigned cvt_pk_bf16(float lo, float hi) { unsigned r; asm volatile("v_cvt_pk_bf16_f32 %0, %1, %2" : "=v"(r) : "v"(lo), "v"(hi)); return r; }
__device__ __forceinline__ u32x4 pack8(const f32x4& v0, const f32x4& v1) { u32x4 w; w.x = cvt_pk_bf16(v0[0], v0[1]); w.y = cvt_pk_bf16(v0[2], v0[3]); w.z = cvt_pk_bf16(v1[0], v1[1]); w.w = cvt_pk_bf16(v1[2], v1[3]); return w; }

struct EpiPlain {
    static constexpr bool PERM = true, AFTER_DRAIN = false;
    bf16_t* O; int ldc;
    __device__ __forceinline__ void operator()(const f32x4 (&acc)[2][2][4][2], const Unit& u, int wr, int wc, int fr, int fq) const {
        const int row0 = u.pm * BM + wr * 64 + fr, col0 = u.pn * BM + wc * 32 + 8 * fq;
#pragma unroll
        for (int ai = 0; ai < 2; ++ai)
#pragma unroll
            for (int m = 0; m < 4; ++m) { bf16_t* rowp = O + (size_t)(row0 + ai * HALF + m * 16) * ldc + col0;
#pragma unroll
                for (int bj = 0; bj < 2; ++bj) *(u32x4*)(rowp + bj * HALF) = pack8(acc[ai][bj][m][0], acc[ai][bj][m][1]); }
    }
};
struct EpiConvIn {
    static constexpr bool PERM = true, AFTER_DRAIN = false;
    bf16_t* U; bf16_t* Bb; const float* rs;
    __device__ __forceinline__ void operator()(const f32x4 (&acc)[2][2][4][2], const Unit& u, int wr, int wc, int fr, int fq) const {
        const int row0 = u.pm * BM + wr * 64 + fr;
        float sv[2][4];
#pragma unroll
        for (int ai = 0; ai < 2; ++ai)
#pragma unroll
            for (int m = 0; m < 4; ++m) sv[ai][m] = rs[row0 + ai * HALF + m * 16];
        __builtin_amdgcn_sched_barrier(0);
        if (u.pn < 16) {
            const int col0 = u.pn * 128 + wc * 32 + 8 * fq;
#pragma unroll
            for (int ai = 0; ai < 2; ++ai)
#pragma unroll
                for (int m = 0; m < 4; ++m) { const int row = row0 + ai * HALF + m * 16; bf16_t* rowp = U + (size_t)row * 2048 + col0; const float s = sv[ai][m], s2 = s * s;
                    *(u32x4*)rowp = pack8(acc[ai][0][m][0] * acc[ai][1][m][0] * s2, acc[ai][0][m][1] * acc[ai][1][m][1] * s2); }
        } else {
            const int col0 = (u.pn - 16) * BM + wc * 32 + 8 * fq;
#pragma unroll
            for (int ai = 0; ai < 2; ++ai)
#pragma unroll
                for (int m = 0; m < 4; ++m) { const int row = row0 + ai * HALF + m * 16; bf16_t* rowp = Bb + (size_t)row * 2048 + col0; const float s = sv[ai][m];
#pragma unroll
                    for (int bj = 0; bj < 2; ++bj) *(u32x4*)(rowp + bj * HALF) = pack8(acc[ai][bj][m][0] * s, acc[ai][bj][m][1] * s); }
        }
    }
};
struct EpiSwiGLU {
    static constexpr bool PERM = true, AFTER_DRAIN = false;
    bf16_t* O; int ldc; const float* rs;
    typedef float f32x2 __attribute__((ext_vector_type(2)));
    static __device__ __forceinline__ f32x2 silu_mul2(f32x2 g, f32x2 up, float sneg, float s2) {
        const f32x2 t = g * sneg; f32x2 e; e.x = __builtin_amdgcn_exp2f(t.x); e.y = __builtin_amdgcn_exp2f(t.y);
        const f32x2 d = e + 1.0f; f32x2 r; r.x = __builtin_amdgcn_rcpf(d.x); r.y = __builtin_amdgcn_rcpf(d.y);
        return (g * up) * (r * s2);
    }
    __device__ __forceinline__ void operator()(const f32x4 (&acc)[2][2][4][2], const Unit& u, int wr, int wc, int fr, int fq) const {
        const int row0 = u.pm * BM + wr * 64 + fr, col0 = u.pn * 128 + wc * 32 + 8 * fq;
        float sv[2][4];
#pragma unroll
        for (int ai = 0; ai < 2; ++ai)
#pragma unroll
            for (int m = 0; m < 4; ++m) sv[ai][m] = rs[row0 + ai * HALF + m * 16];
        __builtin_amdgcn_sched_barrier(0);
#pragma unroll
        for (int ai = 0; ai < 2; ++ai)
#pragma unroll
            for (int m = 0; m < 4; ++m) { const int row = row0 + ai * HALF + m * 16; bf16_t* rowp = O + (size_t)row * ldc + col0; const float s = sv[ai][m], sneg = s * -1.44269504089f, s2 = s * s;
                const f32x4 g0 = acc[ai][0][m][0], g1 = acc[ai][0][m][1], u0 = acc[ai][1][m][0], u1 = acc[ai][1][m][1];
                const f32x2 a = silu_mul2((f32x2){g0[0], g0[1]}, (f32x2){u0[0], u0[1]}, sneg, s2), b = silu_mul2((f32x2){g0[2], g0[3]}, (f32x2){u0[2], u0[3]}, sneg, s2);
                const f32x2 c = silu_mul2((f32x2){g1[0], g1[1]}, (f32x2){u1[0], u1[1]}, sneg, s2), d = silu_mul2((f32x2){g1[2], g1[3]}, (f32x2){u1[2], u1[3]}, sneg, s2);
                __builtin_nontemporal_store(pack8((f32x4){a.x, a.y, b.x, b.y}, (f32x4){c.x, c.y, d.x, d.y}), (u32x4*)rowp); }
    }
};
struct EpiQKV {
    static constexpr bool PERM = true, AFTER_DRAIN = false;
    bf16_t* Q; size_t koff, voff; const f32x4* rope; const float* rs; float qscale;
    __device__ __forceinline__ void operator()(const f32x4 (&acc)[2][2][4][2], const Unit& u, int wr, int wc, int fr, int fq) const {
        const int row0 = u.pm * BM + wr * 64 + fr;
        const int kind = u.pn < 8 ? 0 : (u.pn < 10 ? 1 : 2);
        bf16_t* base = Q + (size_t)(kind >= 1) * koff + (size_t)(kind == 2) * (voff - koff);
        const int ldc = 2048 - 1536 * (kind >= 1);
        const int colt = (u.pn - 8 * (kind >= 1) - 2 * (kind == 2)) * BM;
        const int col0 = colt + wc * 32 + 8 * fq;
        const float sc0 = kind == 0 ? qscale : 1.0f;
        float sv[2][4];
#pragma unroll
        for (int ai = 0; ai < 2; ++ai)
#pragma unroll
            for (int m = 0; m < 4; ++m) sv[ai][m] = rs[row0 + ai * HALF + m * 16];
#pragma unroll
        for (int ai = 0; ai < 2; ++ai) {
            f32x4 csv[4][2];
#pragma unroll
            for (int m = 0; m < 4; ++m) { const int row = row0 + ai * HALF + m * 16; const f32x4* rp = rope + (size_t)(row & 2047) * 32 + 8 * wc + 2 * fq; csv[m][0] = rp[0]; csv[m][1] = rp[1]; }
            __builtin_amdgcn_sched_barrier(0);
#pragma unroll
            for (int m = 0; m < 4; ++m) { const int row = row0 + ai * HALF + m * 16; bf16_t* rowp = base + (size_t)row * ldc + col0; const float sc = sc0 * sv[ai][m];
                f32x4 cs0 = (f32x4){1.f, 0.f, 1.f, 0.f}, cs1 = (f32x4){1.f, 0.f, 1.f, 0.f};
                if (kind != 2) { cs0 = csv[m][0]; cs1 = csv[m][1]; }
#pragma unroll
                for (int bj = 0; bj < 2; ++bj) { const f32x4 a0 = acc[ai][bj][m][0], a1 = acc[ai][bj][m][1]; f32x4 v0, v1;
                    v0[0] = (a0[0] * cs0[0] - a0[1] * cs0[1]) * sc; v0[1] = (a0[1] * cs0[0] + a0[0] * cs0[1]) * sc;
                    v0[2] = (a0[2] * cs0[2] - a0[3] * cs0[3]) * sc; v0[3] = (a0[3] * cs0[2] + a0[2] * cs0[3]) * sc;
                    v1[0] = (a1[0] * cs1[0] - a1[1] * cs1[1]) * sc; v1[1] = (a1[1] * cs1[0] + a1[0] * cs1[1]) * sc;
                    v1[2] = (a1[2] * cs1[2] - a1[3] * cs1[3]) * sc; v1[3] = (a1[3] * cs1[2] + a1[2] * cs1[3]) * sc;
                    *(u32x4*)(rowp + bj * HALF) = pack8(v0, v1); } }
        }
    }
};

template <class Epi, class Sched, bool ALIGN_EPI = false, bool SP2 = false>
__device__ __forceinline__ void gemm_phase(PG8_LAS unsigned char* lds, const Gemm g, const Sched& S, const Epi& E) {
    int tid_ = threadIdx.x, K_ = g.K; asm volatile("" : "+v"(tid_)); asm volatile("" : "+s"(K_));
    const int tid = tid_, wid = __builtin_amdgcn_readfirstlane(tid >> 6), lane = tid & 63, wr = wid >> 2, wc = wid & 3, fr = lane & 15, fq = lane >> 4;
    const int K = K_, nt = K / BK; __builtin_assume(nt >= 4 && (nt & 1) == 0);
    unsigned voffA[2], voffB[2];
#pragma unroll
    for (int i = 0; i < 2; ++i) { int R, C; stage_rc(tid * 16 + i * 8192, R, C); const int Rb = Epi::PERM ? ((R & ~31) + perm32(R & 31)) : R;
        voffA[i] = (unsigned)(R * K + C) * 2u; voffB[i] = (unsigned)(Rb * K + C) * 2u; }
    const size_t kstep = (size_t)(BK * 2);
    const size_t hstep = (size_t)HALF * K * 2;
    const size_t tstep = 2 * hstep;
    const unsigned ldsw = (unsigned)wid * 1024u;
    const int aoff = lds_byte(wr * 64 + fr, fq * 8), boff = lds_byte(wc * 32 + fr, fq * 8);
#define PG8_SA(b, h) (((b) * 2 + (h)) * HTB)
#define PG8_SB(b, h) ((4 + (b) * 2 + (h)) * HTB)
#define PG8_STAGE(bufoff, gbase, voff) do { _Pragma("unroll") for (int _i = 0; _i < 2; ++_i) \
        __builtin_amdgcn_global_load_lds((const unsigned*)((const char*)(gbase) + (voff)[_i]), (PG8_LAS unsigned*)(lds + (bufoff) + ldsw + _i * 8192), 16, 0, 0); } while (0)
#define PG8_LDA(dst, b, h) do { _Pragma("unroll") for (int m = 0; m < 4; ++m) _Pragma("unroll") for (int k = 0; k < 2; ++k) dst[m][k] = *(const PG8_LAS bf16x8*)(lds + PG8_SA(b, h) + aoff + m * 2048 + k * 1024); } while (0)
#define PG8_LDB(dst, b, h) do { _Pragma("unroll") for (int n = 0; n < 2; ++n) _Pragma("unroll") for (int k = 0; k < 2; ++k) dst[n][k] = *(const PG8_LAS bf16x8*)(lds + PG8_SB(b, h) + boff + n * 2048 + k * 1024); } while (0)
#define PG8_MMA(ai, bj, At, Bt) do { __builtin_amdgcn_s_setprio(1); _Pragma("unroll") for (int m = 0; m < 4; ++m) _Pragma("unroll") for (int n = 0; n < 2; ++n) _Pragma("unroll") for (int k = 0; k < 2; ++k) \
        acc[ai][bj][m][n] = __builtin_amdgcn_mfma_f32_16x16x32_bf16(Bt[n][k], At[m][k], acc[ai][bj][m][n], 0, 0, 0); __builtin_amdgcn_s_setprio(0); } while (0)
#define PG8_WAIT_V(n) asm volatile("s_waitcnt vmcnt(" #n ")" ::: "memory")
#define PG8_WAIT_L(n) asm volatile("s_waitcnt lgkmcnt(" #n ")" ::: "memory")
#define PG8_BAR __builtin_amdgcn_s_barrier()
#define PG8_SCHED __builtin_amdgcn_sched_barrier(0)
    Unit cur, nxt; int ui = 0;
    if (!S.next(0, cur)) return;
    f32x4 acc[2][2][4][2];
#pragma unroll
    for (int a = 0; a < 2; ++a)
#pragma unroll
        for (int b = 0; b < 2; ++b)
#pragma unroll
            for (int m = 0; m < 4; ++m)
#pragma unroll
                for (int n = 0; n < 2; ++n) acc[a][b][m][n] = (f32x4){0.f, 0.f, 0.f, 0.f};
    bf16x8 At[4][2], B0[2][2], B1[2][2];
    const char* cA = (const char*)g.A + (size_t)cur.pm * tstep; const char* cB = (const char*)g.Bt + (size_t)cur.pn * tstep;
    S.a_ready(cur);
    if constexpr (SP2) {
        PG8_STAGE(PG8_SB(0, 0), cB, voffB); PG8_STAGE(PG8_SB(0, 1), cB + hstep, voffB); PG8_STAGE(PG8_SA(0, 0), cA, voffA); PG8_STAGE(PG8_SA(0, 1), cA + hstep, voffA);
        if (wr == 1) PG8_BAR;
        PG8_WAIT_V(2); PG8_BAR;
        PG8_STAGE(PG8_SB(1, 0), cB + kstep, voffB); PG8_STAGE(PG8_SA(1, 0), cA + kstep, voffA); PG8_STAGE(PG8_SB(1, 1), cB + hstep + kstep, voffB);
        PG8_WAIT_V(6); PG8_BAR;
    } else {
        PG8_STAGE(PG8_SB(0, 0), cB, voffB); PG8_STAGE(PG8_SA(0, 0), cA, voffA); PG8_STAGE(PG8_SB(0, 1), cB + hstep, voffB); PG8_STAGE(PG8_SA(0, 1), cA + hstep, voffA);
        if (wr == 1) PG8_BAR;
        PG8_WAIT_V(4); PG8_BAR;
        PG8_STAGE(PG8_SB(1, 0), cB + kstep, voffB); PG8_STAGE(PG8_SA(1, 0), cA + kstep, voffA); PG8_STAGE(PG8_SB(1, 1), cB + hstep + kstep, voffB);
        PG8_WAIT_V(6); PG8_BAR;
    }
    for (;;) {
        const bool has_next = S.next(ui + 1, nxt);
        const char* nA = has_next ? (const char*)g.A + (size_t)nxt.pm * tstep : cA; const char* nB = has_next ? (const char*)g.Bt + (size_t)nxt.pn * tstep : cB;
        for (int t = 0; t < nt; t += 2) {
            const bool last = (t == nt - 2);
            const char* a1 = cA + (size_t)(t + 1) * kstep;
            const char* a2 = last ? nA : cA + (size_t)(t + 2) * kstep; const char* b2 = last ? nB : cB + (size_t)(t + 2) * kstep;
            const char* a3 = a2 + kstep; const char* b3 = b2 + kstep;
            if (last && has_next) S.a_ready(nxt);
            if constexpr (SP2) {
            PG8_LDB(B0, 0, 0); PG8_LDB(B1, 0, 1); PG8_SCHED; PG8_LDA(At, 0, 0); PG8_STAGE(PG8_SA(1, 1), a1 + hstep, voffA);
            PG8_WAIT_V(8); PG8_WAIT_L(0); PG8_BAR; PG8_MMA(0, 0, At, B0); PG8_MMA(0, 1, At, B1); PG8_BAR; PG8_SCHED;
            PG8_LDA(At, 0, 1); PG8_STAGE(PG8_SB(0, 0), b2, voffB); PG8_STAGE(PG8_SB(0, 1), b2 + hstep, voffB); PG8_STAGE(PG8_SA(0, 0), a2, voffA);
            PG8_WAIT_V(8); PG8_WAIT_L(0); PG8_BAR; PG8_MMA(1, 0, At, B0); PG8_MMA(1, 1, At, B1); PG8_BAR; PG8_SCHED;
            PG8_LDB(B0, 1, 0); PG8_LDB(B1, 1, 1); PG8_SCHED; PG8_LDA(At, 1, 0); PG8_STAGE(PG8_SA(0, 1), a2 + hstep, voffA);
            PG8_WAIT_V(8); PG8_WAIT_L(0); PG8_BAR; PG8_MMA(0, 0, At, B0); PG8_MMA(0, 1, At, B1); PG8_BAR; PG8_SCHED;
            PG8_LDA(At, 1, 1); PG8_STAGE(PG8_SB(1, 0), b3, voffB); PG8_STAGE(PG8_SB(1, 1), b3 + hstep, voffB); PG8_STAGE(PG8_SA(1, 0), a3, voffA);
            PG8_WAIT_V(8); PG8_WAIT_L(0); PG8_BAR; PG8_MMA(1, 0, At, B0); PG8_MMA(1, 1, At, B1); PG8_BAR; PG8_SCHED;
            } else {
            PG8_LDB(B0, 0, 0); PG8_SCHED; PG8_LDA(At, 0, 0); PG8_STAGE(PG8_SA(1, 1), a1 + hstep, voffA);
            PG8_WAIT_L(8); PG8_BAR; PG8_WAIT_L(0); PG8_MMA(0, 0, At, B0); PG8_BAR; PG8_SCHED;
            PG8_LDB(B1, 0, 1); PG8_STAGE(PG8_SB(0, 0), b2, voffB);
            PG8_BAR; PG8_WAIT_L(0); PG8_MMA(0, 1, At, B1); PG8_BAR;
            PG8_LDA(At, 0, 1); PG8_STAGE(PG8_SA(0, 0), a2, voffA);
            PG8_BAR; PG8_WAIT_L(0); PG8_MMA(1, 0, At, B0); PG8_BAR; PG8_SCHED;
            PG8_STAGE(PG8_SB(0, 1), b2 + hstep, voffB);
            PG8_WAIT_V(6); PG8_BAR; PG8_MMA(1, 1, At, B1); PG8_BAR;
            PG8_LDB(B0, 1, 0); PG8_SCHED; PG8_LDA(At, 1, 0); PG8_STAGE(PG8_SA(0, 1), a2 + hstep, voffA);
            PG8_WAIT_L(8); PG8_BAR; PG8_WAIT_L(0); PG8_MMA(0, 0, At, B0); PG8_BAR; PG8_SCHED;
            PG8_LDB(B1, 1, 1); PG8_STAGE(PG8_SB(1, 0), b3, voffB);
            PG8_BAR; PG8_WAIT_L(0); PG8_MMA(0, 1, At, B1); PG8_BAR;
            PG8_LDA(At, 1, 1); PG8_STAGE(PG8_SA(1, 0), a3, voffA);
            PG8_BAR; PG8_WAIT_L(0); PG8_MMA(1, 0, At, B0); PG8_BAR; PG8_SCHED;
            PG8_STAGE(PG8_SB(1, 1), b3 + hstep, voffB);
            PG8_WAIT_V(6); PG8_BAR; PG8_MMA(1, 1, At, B1); PG8_BAR;
            }
        }
        if constexpr (ALIGN_EPI) { if (wr == 0) PG8_BAR; }
        if constexpr (!Epi::AFTER_DRAIN) { E(acc, cur, wr, wc, fr, fq);
#if PROBE_EPI2
            asm volatile("" ::: "memory"); E(acc, cur, wr, wc, fr, fq);
#endif
            S.done(cur); }
        if (!has_next) break;
#pragma unroll
        for (int a = 0; a < 2; ++a)
#pragma unroll
            for (int b = 0; b < 2; ++b)
#pragma unroll
                for (int m = 0; m < 4; ++m)
#pragma unroll
                    for (int n = 0; n < 2; ++n) acc[a][b][m][n] = (f32x4){0.f, 0.f, 0.f, 0.f};
        cur = nxt; cA = nA; cB = nB; ++ui;
        if constexpr (ALIGN_EPI) { if (wr == 1) PG8_BAR; }
    }
    PG8_WAIT_V(0);
    if constexpr (!ALIGN_EPI) { if (wr == 0) PG8_BAR; }
    PG8_BAR;
    if constexpr (Epi::AFTER_DRAIN) { E.fused(acc, cur, wr, wc, fr, fq, lds, wid, lane); S.done(cur); }
#undef PG8_SA
#undef PG8_SB
#undef PG8_STAGE
#undef PG8_LDA
#undef PG8_LDB
#undef PG8_MMA
#undef PG8_WAIT_V
#undef PG8_WAIT_L
#undef PG8_BAR
#undef PG8_SCHED
}
}
namespace attn {
#define ATT_LAS __attribute__((address_space(3)))
typedef unsigned short bf16;
typedef short bf16x8 __attribute__((ext_vector_type(8)));
typedef short s16x4 __attribute__((ext_vector_type(4)));
typedef float f32x16 __attribute__((ext_vector_type(16)));
typedef unsigned u32x4 __attribute__((ext_vector_type(4)));
typedef unsigned u32x2 __attribute__((ext_vector_type(2)));
constexpr int SEQ = 2048, DMODEL = 2048, KVW = 512, HD = 128, CHUNK = 64, CHUNK_BYTES = CHUNK * HD * 2;
constexpr int NSLOT = 4, ATT_LDS_BYTES = 2 * NSLOT * CHUNK_BYTES;
constexpr int NUNITS = 20 * 4 * 32;
__device__ __forceinline__ unsigned off_b(unsigned row, unsigned ch) { return 256u * row + 16u * (ch ^ (((row & 3) << 2) | ((row >> 2) & 3))); }
__device__ __forceinline__ unsigned tr_read_addr(unsigned lane, unsigned c, unsigned ks, unsigned t) {
    const unsigned h = lane >> 5, blk = (lane >> 4) & 1, q = (lane & 15) >> 2, p = lane & 3;
    return off_b(16 * ks + 8 * h + 4 * t + q, 4 * c + 2 * blk + (p >> 1)) + 8 * (p & 1);
}
__device__ __forceinline__ unsigned cvt_pk(float lo, float hi) { unsigned r; asm volatile("v_cvt_pk_bf16_f32 %0, %1, %2" : "=v"(r) : "v"(lo), "v"(hi)); return r; }
__device__ __forceinline__ s16x4 vtr(const ATT_LAS unsigned char* p) { typedef short v4i16_t __attribute__((ext_vector_type(4))); return __builtin_bit_cast(s16x4, __builtin_amdgcn_ds_read_tr16_b64_v4i16((ATT_LAS v4i16_t*)p)); }

__device__ __forceinline__ void attn_unit(int b, int kh, int qb, const bf16* __restrict__ Qg, bf16* __restrict__ Og, const bf16* __restrict__ Kg, const bf16* __restrict__ Vg, const float* __restrict__ sink, ATT_LAS unsigned char* lds) {
    int tid_ = threadIdx.x; asm volatile("" : "+v"(tid_));
    const int tid = tid_, wid = __builtin_amdgcn_readfirstlane(tid >> 6), lane = tid & 63, r = lane & 31, h = lane >> 5;
    const int g = wid & 3, sub = wid >> 2, head = kh * 4 + g;
    const int qpos0 = qb * 64 + sub * 32;
    const size_t rowbase = (size_t)b * SEQ;
    const bf16* qrow = Qg + (rowbase + qpos0 + r) * DMODEL + head * HD; bf16* orow = Og + (rowbase + qpos0 + r) * DMODEL + head * HD;
    bf16x8 qf[8];
#pragma unroll
    for (int s = 0; s < 8; ++s) qf[s] = *(const bf16x8*)(qrow + 16 * s + 8 * h);
    float m_run = sink[head] * 1.44269504089f, l_run = (h == 0) ? 1.0f : 0.0f;
    f32x16 o[4];
#pragma unroll
    for (int c = 0; c < 4; ++c)
#pragma unroll
        for (int i = 0; i < 16; ++i) o[c][i] = 0.f;
    const int kc_first = qb * 64 - 128;
    const int c_lo = kc_first < 0 ? (-kc_first) / 64 : 0;
    int c_hi = 4; while (kc_first + 64 * c_hi >= SEQ) --c_hi;
    const bf16* kg[2]; const bf16* vg[2];
#pragma unroll
    for (int i = 0; i < 2; ++i) { const int srow = 4 * (2 * wid + i) + (lane >> 4), pos = lane & 15, sch = pos ^ (((srow & 3) << 2) | ((srow >> 2) & 3));
        const size_t eo = (rowbase + (size_t)(kc_first + srow)) * KVW + kh * HD + sch * 8; kg[i] = Kg + eo; vg[i] = Vg + eo; }
#define ATT_STAGE(c, buf) do { _Pragma("unroll") for (int _i = 0; _i < 2; ++_i) { \
        __builtin_amdgcn_global_load_lds((const unsigned*)(kg[_i] + (size_t)(64 * (c)) * KVW), (ATT_LAS unsigned*)(lds + (buf) * CHUNK_BYTES + (2 * wid + _i) * 1024), 16, 0, 0); \
        __builtin_amdgcn_global_load_lds((const unsigned*)(vg[_i] + (size_t)(64 * (c)) * KVW), (ATT_LAS unsigned*)(lds + (NSLOT + (buf)) * CHUNK_BYTES + (2 * wid + _i) * 1024), 16, 0, 0); } } while (0)
    const int rp = (r & 0x13) | ((r & 4) << 1) | ((r & 8) >> 1);
    const unsigned kbase0 = 256u * rp + 16u * ((unsigned)h ^ (((rp & 3) << 2) | ((rp >> 2) & 3)));
    unsigned vbase0[2];
    { const unsigned blk = (lane >> 4) & 1, q = (lane & 15) >> 2, p = lane & 3;
#pragma unroll
      for (int t = 0; t < 2; ++t) vbase0[t] = 2048u * h + 1024u * t + 256u * q + 64u * q + 16u * ((2 * blk + (p >> 1)) ^ (2 * h + t)) + 8u * (p & 1); }
    asm volatile("s_waitcnt lgkmcnt(0)" ::: "memory"); __builtin_amdgcn_s_barrier(); asm volatile("" ::: "memory");
#pragma unroll
    for (int j = 0; j < NSLOT - 1; ++j) if (c_lo + j <= c_hi) ATT_STAGE(c_lo + j, j);
    for (int c = c_lo; c <= c_hi; ++c) {
        const int idx = c - c_lo, cur = idx & (NSLOT - 1), ahead = (c_hi - c) < (NSLOT - 2) ? (c_hi - c) : (NSLOT - 2);
        if (ahead >= 2) asm volatile("s_waitcnt vmcnt(8)" ::: "memory"); else if (ahead == 1) asm volatile("s_waitcnt vmcnt(4)" ::: "memory"); else asm volatile("s_waitcnt vmcnt(0)" ::: "memory");
        asm volatile("s_waitcnt lgkmcnt(0)" ::: "memory"); __builtin_amdgcn_s_barrier(); asm volatile("" ::: "memory");
        if (c + NSLOT - 1 <= c_hi) ATT_STAGE(c + NSLOT - 1, (idx + NSLOT - 1) & (NSLOT - 1));
        unsigned kbase = kbase0, vbase[2] = {vbase0[0], vbase0[1]}; asm volatile("" : "+v"(kbase), "+v"(vbase[0]), "+v"(vbase[1]));
        const ATT_LAS unsigned char* kb = lds + cur * CHUNK_BYTES; const ATT_LAS unsigned char* vb = lds + (NSLOT + cur) * CHUNK_BYTES;
        const int d00 = kc_first + 64 * c - qpos0, d01 = d00 + 32;
        const bool n0 = (d00 >= -128 && d00 <= 128), n1 = (d01 >= -128 && d01 <= 128);
        if (n0 || n1) {
            f32x16 s0, s1;
#pragma unroll
            for (int i = 0; i < 16; ++i) { s0[i] = n0 ? -m_run : -1e30f; s1[i] = n1 ? -m_run : -1e30f; }
            if (n0) { bf16x8 ka[8];
#pragma unroll
                for (int ks = 0; ks < 8; ++ks) ka[ks] = *(const ATT_LAS bf16x8*)(kb + (kbase ^ (32u * ks)));
                __builtin_amdgcn_sched_barrier(0);
#pragma unroll
                for (int ks = 0; ks < 8; ++ks) s0 = __builtin_amdgcn_mfma_f32_32x32x16_bf16(ka[ks], qf[ks], s0, 0, 0, 0); }
            if (n1) { bf16x8 ka[8];
#pragma unroll
                for (int ks = 0; ks < 8; ++ks) ka[ks] = *(const ATT_LAS bf16x8*)(kb + 8192 + (kbase ^ (32u * ks)));
                __builtin_amdgcn_sched_barrier(0);
#pragma unroll
                for (int ks = 0; ks < 8; ++ks) s1 = __builtin_amdgcn_mfma_f32_32x32x16_bf16(ka[ks], qf[ks], s1, 0, 0, 0); }
            s16x4 va[16];
            { const int t = n0 ? 0 : 1;
#pragma unroll
              for (int cc = 0; cc < 4; ++cc)
#pragma unroll
                  for (int ks = 0; ks < 2; ++ks) { va[4 * cc + 2 * ks] = vtr(vb + t * 8192 + 4096 * ks + (vbase[0] ^ (64u * cc))); va[4 * cc + 2 * ks + 1] = vtr(vb + t * 8192 + 4096 * ks + (vbase[1] ^ (64u * cc))); } }
            if (d00 == -128 || d00 == 128) {
#pragma unroll
                for (int i = 0; i < 16; ++i) { const int a = i >> 2, e = i & 3; const int kk = e + 4 * (a & 1) + 8 * h + 16 * (a >> 1); const int dd = d00 + kk - r; if (dd > 128 || dd < -128) s0[i] = -1e30f; }
            }
            if (d01 == -128 || d01 == 128) {
#pragma unroll
                for (int i = 0; i < 16; ++i) { const int a = i >> 2, e = i & 3; const int kk = e + 4 * (a & 1) + 8 * h + 16 * (a >> 1); const int dd = d01 + kk - r; if (dd > 128 || dd < -128) s1[i] = -1e30f; }
            }
            float mt = fmaxf(s0[0], s1[0]);
#pragma unroll
            for (int i = 1; i < 16; ++i) mt = fmaxf(mt, fmaxf(s0[i], s1[i]));
            mt = fmaxf(mt, __shfl_xor(mt, 32));
            if (!__all(mt <= 8.0f)) {
                const float delta = fmaxf(mt, 0.f), alpha = __builtin_amdgcn_exp2f(-delta);
                m_run += delta; l_run *= alpha;
#pragma unroll
                for (int i = 0; i < 16; ++i) { s0[i] -= delta; s1[i] -= delta; }
#pragma unroll
                for (int cc = 0; cc < 4; ++cc)
#pragma unroll
                    for (int i = 0; i < 16; ++i) o[cc][i] *= alpha;
            }
            float ps = 0.f;
#pragma unroll
            for (int i = 0; i < 16; ++i) { s0[i] = __builtin_amdgcn_exp2f(s0[i]); s1[i] = __builtin_amdgcn_exp2f(s1[i]); ps += s0[i] + s1[i]; }
            l_run += ps;
            bf16x8 pa[2], pb[2];
#pragma unroll
            for (int ks = 0; ks < 2; ++ks) { u32x4 w; w.x = cvt_pk(s0[8 * ks + 0], s0[8 * ks + 1]); w.y = cvt_pk(s0[8 * ks + 2], s0[8 * ks + 3]); w.z = cvt_pk(s0[8 * ks + 4], s0[8 * ks + 5]); w.w = cvt_pk(s0[8 * ks + 6], s0[8 * ks + 7]); pa[ks] = __builtin_bit_cast(bf16x8, w);
                u32x4 w1; w1.x = cvt_pk(s1[8 * ks + 0], s1[8 * ks + 1]); w1.y = cvt_pk(s1[8 * ks + 2], s1[8 * ks + 3]); w1.z = cvt_pk(s1[8 * ks + 4], s1[8 * ks + 5]); w1.w = cvt_pk(s1[8 * ks + 6], s1[8 * ks + 7]); pb[ks] = __builtin_bit_cast(bf16x8, w1); }
            s16x4 vb2[16];
            if (n0 && n1) {
#pragma unroll
                for (int cc = 0; cc < 4; ++cc)
#pragma unroll
                    for (int ks = 0; ks < 2; ++ks) { vb2[4 * cc + 2 * ks] = vtr(vb + 8192 + 4096 * ks + (vbase[0] ^ (64u * cc))); vb2[4 * cc + 2 * ks + 1] = vtr(vb + 8192 + 4096 * ks + (vbase[1] ^ (64u * cc))); }
            }
            __builtin_amdgcn_sched_barrier(0);
#pragma unroll
            for (int cc = 0; cc < 4; ++cc)
#pragma unroll
                for (int ks = 0; ks < 2; ++ks) { const bf16x8 vf = __builtin_shufflevector(va[4 * cc + 2 * ks], va[4 * cc + 2 * ks + 1], 0, 1, 2, 3, 4, 5, 6, 7);
                    o[cc] = __builtin_amdgcn_mfma_f32_32x32x16_bf16(vf, n0 ? pa[ks] : pb[ks], o[cc], 0, 0, 0); }
            if (n0 && n1) {
#pragma unroll
                for (int cc = 0; cc < 4; ++cc)
#pragma unroll
                    for (int ks = 0; ks < 2; ++ks) { const bf16x8 vf = __builtin_shufflevector(vb2[4 * cc + 2 * ks], vb2[4 * cc + 2 * ks + 1], 0, 1, 2, 3, 4, 5, 6, 7);
                        o[cc] = __builtin_amdgcn_mfma_f32_32x32x16_bf16(vf, pb[ks], o[cc], 0, 0, 0); }
            }
        }
    }
    const float lt = l_run + __shfl_xor(l_run, 32), inv = 1.0f / lt;
#pragma unroll
    for (int cc = 0; cc < 4; ++cc)
#pragma unroll
        for (int a = 0; a < 4; a += 2) {
            unsigned ax = cvt_pk(o[cc][4 * a + 0] * inv, o[cc][4 * a + 1] * inv), ay = cvt_pk(o[cc][4 * a + 2] * inv, o[cc][4 * a + 3] * inv);
            unsigned bx = cvt_pk(o[cc][4 * a + 4] * inv, o[cc][4 * a + 5] * inv), by = cvt_pk(o[cc][4 * a + 6] * inv, o[cc][4 * a + 7] * inv);
            { const auto rx = __builtin_amdgcn_permlane32_swap(ax, bx, false, false); ax = rx[0]; bx = rx[1]; }
            { const auto ry = __builtin_amdgcn_permlane32_swap(ay, by, false, false); ay = ry[0]; by = ry[1]; }
            u32x4 w; w.x = ax; w.y = ay; w.z = bx; w.w = by;
            *(u32x4*)(orow + 32 * cc + 8 * a + 8 * h) = w; }
#undef ATT_STAGE
}
}

constexpr int NWAVES = 8;
constexpr int DM = 2048, FF = 5632, NQKV = 3072, SEQ = 2048, NSEQ = 20, M = NSEQ * SEQ, MP = 16 * SEQ, DEPTH = 4;
constexpr float EPS = 1e-6f;
#ifndef PROBE_P0_VALU
#define PROBE_P0_VALU 0
#endif
#ifndef TWO_GROUPS
#define TWO_GROUPS 1
#endif

constexpr size_t MiB = 1u << 20;
constexpr size_t WS_CTL = 0, CTL_ZERO_BYTES = 1 * MiB;
constexpr size_t WS_ROPE = 1 * MiB;
constexpr size_t WS_RS = 2 * MiB;
constexpr size_t WS_W = 3 * MiB;
constexpr size_t SZ_WIN = (size_t)3 * DM * DM * 2, SZ_WSQ = (size_t)DM * DM * 2, SZ_WQKV = (size_t)NQKV * DM * 2, SZ_WGU = (size_t)2 * FF * DM * 2, SZ_WD = (size_t)DM * FF * 2;
constexpr size_t WS_WIN = WS_W, WS_WOUT = WS_WIN + 2 * SZ_WIN, WS_WQKV = WS_WOUT + 2 * SZ_WSQ, WS_WO = WS_WQKV + 2 * SZ_WQKV;
constexpr size_t WS_X = WS_WO + 2 * SZ_WSQ;
constexpr size_t WS_Y = WS_X + (size_t)M * DM * 2;
constexpr size_t WS_R = WS_Y + (size_t)M * DM * 2;
constexpr size_t WS_END = WS_R + (size_t)M * FF * 2;
static_assert(WS_X == 107 * MiB && WS_END == 867 * MiB, "d_ws map");
constexpr size_t OUT_WGU = 0, OUT_WD = 4 * SZ_WGU;
static_assert(OUT_WD + 4 * SZ_WD <= (size_t)M * DM * 4, "d_out scratch map");
constexpr int CW_BAR = 4096;
constexpr int CW_FLAG = 64;

constexpr int RING_OFF = 0, RING_BYTES = 131072;
constexpr int LDSCTL_OFF = RING_BYTES, MISC_OFF = LDSCTL_OFF + 320;
constexpr int LDS_BYTES = 147456;
static_assert(MISC_OFF + 128 <= LDS_BYTES, "LDS map");
static_assert(attn::ATT_LDS_BYTES <= RING_BYTES, "attention LDS");

#define GAS __attribute__((address_space(1)))
#define LAS __attribute__((address_space(3)))
typedef unsigned short bf16;
typedef unsigned v4u __attribute__((ext_vector_type(4)));
typedef float f32x4 __attribute__((ext_vector_type(4)));
typedef GAS unsigned gu32;
#define RLX_AGENT __ATOMIC_RELAXED, __HIP_MEMORY_SCOPE_AGENT
#define LDS_WAIT() asm volatile("s_waitcnt lgkmcnt(0)" ::: "memory")
__device__ __forceinline__ unsigned f2bf(float f) { unsigned u = __builtin_bit_cast(unsigned, f); return (u + 0x7fffu + ((u >> 16) & 1u)) >> 16; }
__device__ __forceinline__ unsigned pk2(float lo, float hi) { unsigned r; asm("v_cvt_pk_bf16_f32 %0, %1, %2" : "=v"(r) : "v"(lo), "v"(hi)); return r; }
__device__ __forceinline__ float bflo(unsigned w) { return __builtin_bit_cast(float, w << 16); }
__device__ __forceinline__ float bfhi(unsigned w) { return __builtin_bit_cast(float, w & 0xffff0000u); }

#define XB_TMO      128
#define XB_XCNT(j)  (256  + 64 * (j))
#define XB_XSUB(j)  (1280 + 64 * (j))
#define XB_XGEN(j)  (2304 + 64 * (j))
#define XB_TOP      3328
#define XB_TOPGEN   3392
#define XCD_BAR_WORDS 3456
#define XB_SPIN_CAP (1u << 18)

__device__ __forceinline__ unsigned xb_ld(unsigned* p)              { return __hip_atomic_load(p, __ATOMIC_RELAXED, __HIP_MEMORY_SCOPE_AGENT); }
__device__ __forceinline__ unsigned xb_add(unsigned* p, unsigned v) { return __hip_atomic_fetch_add(p, v, __ATOMIC_RELAXED, __HIP_MEMORY_SCOPE_AGENT); }
__device__ __forceinline__ unsigned xb_xcc_id() { return (unsigned)__builtin_amdgcn_s_getreg((3 << 11) | 20) & 0xFu; }
#define XB_SPIN(cond, bar) do { unsigned _sp = 0; while (cond) { __builtin_amdgcn_s_sleep(1); \
    if ((++_sp & 255u) == 0u) { if (xb_ld(&(bar)[XB_TMO])) break; if (_sp > XB_SPIN_CAP) { atomicAdd(&(bar)[XB_TMO], 1u); break; } } } } while (0)

struct XcdBarrier {
    unsigned* bar; unsigned x; unsigned total;
    volatile LAS unsigned* st;
};

__device__ __forceinline__ XcdBarrier xcd_barrier_post(unsigned* bar, volatile LAS unsigned* st, unsigned total) {
    XcdBarrier b; b.bar = bar; b.x = xb_xcc_id(); b.st = st; b.total = total;
    if (threadIdx.x == 0) (void)xb_add(&bar[XB_XCNT(b.x)], 1u);
    return b;
}
__device__ __forceinline__ void xcd_barrier_complete(unsigned* bar, unsigned x, unsigned G, unsigned& nloc, unsigned& nx) {
    unsigned sum, cnt, mine, sp = 0u;
    for (;;) {
        sum = 0u; cnt = 0u; mine = 0u;
#pragma unroll
        for (unsigned j = 0; j < 16; ++j) { const unsigned c = xb_ld(&bar[XB_XCNT(j)]); sum += c; cnt += (c > 0u) ? 1u : 0u; }
        mine = xb_ld(&bar[XB_XCNT(x)]);
        if (sum == G) break;
        __builtin_amdgcn_s_sleep(1);
        if ((++sp & 255u) == 0u) { if (xb_ld(&bar[XB_TMO])) break; if (sp > XB_SPIN_CAP) { atomicAdd(&bar[XB_TMO], 1u); break; } }
    }
    nloc = mine > 0u ? mine : 1u; nx = cnt > 0u ? cnt : 1u;
}

__device__ __forceinline__ void xcd_barrier(const XcdBarrier& b) {
    asm volatile("s_waitcnt vmcnt(0)" ::: "memory");
    __syncthreads();
    if (threadIdx.x == 0) {
        unsigned* bar = b.bar;
        __builtin_amdgcn_s_waitcnt(0);
        unsigned nloc = b.st[0], nx = b.st[1];
        if (nloc == 0u) { xcd_barrier_complete(bar, b.x, b.total, nloc, nx); b.st[0] = nloc; b.st[1] = nx; }
        const unsigned old = xb_add(&bar[XB_XSUB(b.x)], 1u);
        const unsigned gen = old / nloc;
        if (old + 1u == (gen + 1u) * nloc) {
            __builtin_amdgcn_fence(__ATOMIC_RELEASE, "agent");
            asm volatile("s_waitcnt vmcnt(0)" ::: "memory");
            const unsigned og = xb_add(&bar[XB_TOP], 1u);
            const unsigned tg = og / nx;
            if (og + 1u == (tg + 1u) * nx) xb_add(&bar[XB_TOPGEN], 1u);
            else XB_SPIN(xb_ld(&bar[XB_TOPGEN]) == tg, bar);
            __builtin_amdgcn_fence(__ATOMIC_ACQUIRE, "agent");
            xb_add(&bar[XB_XGEN(b.x)], 1u);
            asm volatile("s_waitcnt vmcnt(0)" ::: "memory");
        } else {
            XB_SPIN(xb_ld(&bar[XB_XGEN(b.x)]) == gen, bar);
            __builtin_amdgcn_fence(__ATOMIC_ACQUIRE, "agent");
            asm volatile("s_waitcnt vmcnt(0)" ::: "memory");
        }
    }
    __syncthreads();
}


struct Frame {
    LAS unsigned char* lds;
    int tid, lane, wave;
    int vcu, G;
    int r0, mr;
    const float *xp, *xs; float* out; float* rs;
    bf16 *X, *Y, *R;
};

__device__ __forceinline__ float wave_sum(float v) {
#pragma unroll
    for (int o = 1; o < 64; o <<= 1) v += __shfl_xor(v, o);
    return v;
}
template <int MODE> __device__ __forceinline__ int map_row(int n) {
    if (MODE == 1) { if (n < 2048) return 4096 + n; const int ch = (n - 2048) & 2047; return 256 * (ch >> 7) + (n >= 4096 ? 128 : 0) + (ch & 127); }
    if (MODE == 2) { if (n >= 2560) return n; const int d = n & 127; return (n & ~127) + 2 * (d & 63) + (d >> 6); }
    if (MODE == 3) return 256 * (n >> 7) + (n & 127);
    if (MODE == 4) return 256 * (n >> 7) + 128 + (n & 127);
    return n;
}
template <int N_> __device__ __forceinline__ void p0_load(const float* W, const float* gk, int item, int lane, float (&wv)[32], float& gl) {
    constexpr int nblk = N_ / 32; const int kb = item / nblk, nb = item % nblk, k0 = 64 * kb, n0 = 32 * nb;
    gl = gk ? gk[k0 + lane] : 1.0f;
#pragma unroll
    for (int i = 0; i < 32; ++i) { const int kk = 2 * i + (lane >> 5); wv[i] = __builtin_nontemporal_load(W + (size_t)(k0 + kk) * N_ + n0 + (lane & 31)); }
}
template <int MODE, int N_> __device__ __forceinline__ void p0_store(const float (&wv)[32], float gl, int K, bf16* WT, LAS float* scr, int item, int lane) {
    constexpr int nblk = N_ / 32; const int kb = item / nblk, nb = item % nblk, k0 = 64 * kb, n0 = 32 * nb;
#pragma unroll
    for (int i = 0; i < 32; ++i) { const int kk = 2 * i + (lane >> 5); scr[kk * 33 + (lane & 31)] = wv[i] * __shfl(gl, kk); }
#if PROBE_P0_VALU
    { float dv = gl; for (int q = 0; q < PROBE_P0_VALU; ++q) { asm volatile("v_fma_f32 %0, %0, %0, %0" : "+v"(dv)); } asm volatile("" :: "v"(dv)); }
#endif
    LDS_WAIT(); asm volatile("" ::: "memory");
    const int c = lane & 7;
#pragma unroll
    for (int j = 0; j < 4; ++j) { const int n = (lane >> 3) + 8 * j; const LAS float* s = scr + (8 * c) * 33 + n;
        v4u o; o.x = pk2(s[0 * 33], s[1 * 33]); o.y = pk2(s[2 * 33], s[3 * 33]); o.z = pk2(s[4 * 33], s[5 * 33]); o.w = pk2(s[6 * 33], s[7 * 33]);
        *(GAS v4u*)(WT + (size_t)map_row<MODE>(n0 + n) * K + k0 + 8 * c) = o; }
    LDS_WAIT(); asm volatile("" ::: "memory");
}
__device__ __forceinline__ void unpack8v(const v4u& w, f32x4& a, f32x4& b) { a = (f32x4){bflo(w.x), bfhi(w.x), bflo(w.y), bfhi(w.y)}; b = (f32x4){bflo(w.z), bfhi(w.z), bflo(w.w), bfhi(w.w)}; }
__device__ __forceinline__ void norm_load(const Frame& F, int m0, int lane, v4u (&yv)[2][4], v4u (&xv)[2][4]) {
#pragma unroll
    for (int rr = 0; rr < 2; ++rr)
#pragma unroll
        for (int j = 0; j < 4; ++j) { yv[rr][j] = __builtin_nontemporal_load((const v4u*)(F.Y + (size_t)(m0 + rr) * DM + 512 * j + 8 * lane)); xv[rr][j] = __builtin_nontemporal_load((const v4u*)(F.X + (size_t)(m0 + rr) * DM + 512 * j + 8 * lane)); }
}
template <int MODE> __device__ __forceinline__ void norm_compute(const Frame& F, int m0, int lane, const v4u (&yv)[2][4], const v4u (&xv)[2][4], const f32x4 (&gp)[8], float upd) {
#pragma unroll
    for (int rr = 0; rr < 2; ++rr) {
        f32x4 yf[8], xf[8]; float ss = 0.f;
#pragma unroll
        for (int j = 0; j < 4; ++j) { unpack8v(yv[rr][j], yf[2 * j], yf[2 * j + 1]); unpack8v(xv[rr][j], xf[2 * j], xf[2 * j + 1]); }
#pragma unroll
        for (int k = 0; k < 8; ++k) ss += (yf[k][0] * yf[k][0] + yf[k][1] * yf[k][1]) + (yf[k][2] * yf[k][2] + yf[k][3] * yf[k][3]);
        const float r1 = upd / sqrtf(wave_sum(ss) * (1.0f / DM) + EPS);
#pragma unroll
        for (int k = 0; k < 8; ++k) xf[k] = xf[k] + (yf[k] * r1) * gp[k];
        if (MODE == 2) { float* xo = F.out + (size_t)(m0 + rr) * DM;
#pragma unroll
            for (int j = 0; j < 4; ++j)
#pragma unroll
                for (int q = 0; q < 2; ++q) __builtin_nontemporal_store(xf[2 * j + q], (f32x4*)(xo + 512 * j + 8 * lane + 4 * q));
        } else { float s2 = 0.f;
#pragma unroll
            for (int k = 0; k < 8; ++k) s2 += (xf[k][0] * xf[k][0] + xf[k][1] * xf[k][1]) + (xf[k][2] * xf[k][2] + xf[k][3] * xf[k][3]);
            const float r2 = 1.0f / sqrtf(wave_sum(s2) * (1.0f / DM) + EPS);
            bf16* xo = F.X + (size_t)(m0 + rr) * DM;
#pragma unroll
            for (int j = 0; j < 4; ++j) { const f32x4 a = xf[2 * j], b = xf[2 * j + 1]; v4u o; o.x = pk2(a[0], a[1]); o.y = pk2(a[2], a[3]); o.z = pk2(b[0], b[1]); o.w = pk2(b[2], b[3]); *(v4u*)(xo + 512 * j + 8 * lane) = o; }
            if (lane == 0) F.rs[m0 + rr] = r2; }
    }
}
template <int MODE> __device__ __forceinline__ void norm_phase(Frame& F, const float* gpost, const float upd = 1.0f) {
    int lane_ = F.lane; asm volatile("" : "+v"(lane_)); const int lane = lane_;
    const int gw = F.vcu * NWAVES + F.wave, NGW = F.G * NWAVES;
    f32x4 gp[8];
#pragma unroll
    for (int j = 0; j < 4; ++j)
#pragma unroll
        for (int q = 0; q < 2; ++q) gp[2 * j + q] = (MODE != 0) ? *(const f32x4*)(gpost + 512 * j + 8 * lane + 4 * q) : (f32x4){0.f, 0.f, 0.f, 0.f};
    if (MODE == 0) {
        for (int pr = gw; pr < F.mr / 2; pr += NGW) {
            const int m0 = F.r0 + 2 * pr;
            const float* xr = (m0 < MP) ? F.xp + (size_t)m0 * DM : F.xs + (size_t)(m0 - MP) * DM;
            f32x4 x[2][8];
#pragma unroll
            for (int rr = 0; rr < 2; ++rr)
#pragma unroll
                for (int j = 0; j < 4; ++j)
#pragma unroll
                    for (int q = 0; q < 2; ++q) x[rr][2 * j + q] = __builtin_nontemporal_load((const f32x4*)(xr + (size_t)rr * DM + 512 * j + 8 * lane + 4 * q));
#pragma unroll
            for (int rr = 0; rr < 2; ++rr) { float s2 = 0.f;
#pragma unroll
                for (int k = 0; k < 8; ++k) s2 += (x[rr][k][0] * x[rr][k][0] + x[rr][k][1] * x[rr][k][1]) + (x[rr][k][2] * x[rr][k][2] + x[rr][k][3] * x[rr][k][3]);
                const float r2 = 1.0f / sqrtf(wave_sum(s2) * (1.0f / DM) + EPS);
                bf16* xo = F.X + (size_t)(m0 + rr) * DM;
#pragma unroll
                for (int j = 0; j < 4; ++j) { const f32x4 a = x[rr][2 * j], b = x[rr][2 * j + 1]; v4u o; o.x = pk2(a[0], a[1]); o.y = pk2(a[2], a[3]); o.z = pk2(b[0], b[1]); o.w = pk2(b[2], b[3]); *(v4u*)(xo + 512 * j + 8 * lane) = o; }
                if (lane == 0) F.rs[m0 + rr] = r2; }
        }
    } else {
        for (int pr = gw; pr < F.mr / 2; pr += NGW) { v4u ya[2][4], xa[2][4]; norm_load(F, F.r0 + 2 * pr, lane, ya, xa); norm_compute<MODE>(F, F.r0 + 2 * pr, lane, ya, xa, gp, upd); }
    }
}
__device__ __forceinline__ void unpack8(const v4u& w, float (&f)[8]) { f[0] = bflo(w.x); f[1] = bfhi(w.x); f[2] = bflo(w.y); f[3] = bfhi(w.y); f[4] = bflo(w.z); f[5] = bfhi(w.z); f[6] = bflo(w.w); f[7] = bfhi(w.w); }
__device__ __forceinline__ void conv_phase(Frame& F, bf16* Bb, const bf16* U, const float* wdw) {
    int lane_ = F.lane; asm volatile("" : "+v"(lane_)); const int lane = lane_;
    const int gw = F.vcu * NWAVES + F.wave, NGW = F.G * NWAVES;
    constexpr int RUN = 32; const int NTASK = (F.mr / RUN) * 4;
    for (int t = gw; t < NTASK; t += NGW) {
        const int cc = t & 3, row0 = (t >> 2) * RUN,
                  col = 512 * cc + 8 * lane, s0 = row0 & (SEQ - 1);
        float w0[8], w1[8], w2[8];
#pragma unroll
        for (int q = 0; q < 2; ++q) { const f32x4 a = *(const f32x4*)(wdw + col + 4 * q), b = *(const f32x4*)(wdw + DM + col + 4 * q), c = *(const f32x4*)(wdw + 2 * DM + col + 4 * q);
#pragma unroll
            for (int e = 0; e < 4; ++e) { w0[4 * q + e] = a[e]; w1[4 * q + e] = b[e]; w2[4 * q + e] = c[e]; } }
        const bf16* up = U + (size_t)row0 * DM + col; bf16* bp = Bb + (size_t)row0 * DM + col;
        float uprev[8], ucur[8];
        { const v4u a = *(const v4u*)(s0 == 0 ? up : up - DM), b = *(const v4u*)up; unpack8(a, uprev); unpack8(b, ucur);
          if (s0 == 0) {
#pragma unroll
              for (int e = 0; e < 8; ++e) uprev[e] = 0.f; } }
#pragma unroll 1
        for (int g = 0; g < RUN; g += 8) {
            v4u un[8], bb[8];
#pragma unroll
            for (int i = 0; i < 8; ++i) { const int rr = g + i; const bool last = (s0 + rr == SEQ - 1); un[i] = *(const v4u*)(up + (size_t)(last ? rr : rr + 1) * DM); bb[i] = __builtin_nontemporal_load((const v4u*)(bp + (size_t)rr * DM)); }
#pragma unroll
            for (int i = 0; i < 8; ++i) { const int rr = g + i; const bool last = (s0 + rr == SEQ - 1);
                float unx[8], bf[8]; unpack8(un[i], unx); unpack8(bb[i], bf);
                if (last) {
#pragma unroll
                    for (int e = 0; e < 8; ++e) unx[e] = 0.f; }
                float o[8];
#pragma unroll
                for (int e = 0; e < 8; ++e) { o[e] = bf[e] * (w0[e] * uprev[e] + w1[e] * ucur[e] + w2[e] * unx[e]); uprev[e] = ucur[e]; ucur[e] = unx[e]; }
                v4u w; w.x = pk2(o[0], o[1]); w.y = pk2(o[2], o[3]); w.z = pk2(o[4], o[5]); w.w = pk2(o[6], o[7]);
                *(v4u*)(bp + (size_t)rr * DM) = w; }
        }
    }
}
__device__ __forceinline__ void convert_layer(Frame& F, const float* const* in, unsigned char* ws, unsigned char* ob, int L) {
    int lane_ = F.lane; asm volatile("" : "+v"(lane_)); const int lane = lane_;
    LAS float* scr = (LAS float*)(F.lds + RING_OFF + F.wave * 16384);
    const int gw = F.vcu * NWAVES + F.wave, NGW = F.G * NWAVES;
    constexpr int I_WIN = (DM / 64) * (3 * DM / 32), I_SQ = (DM / 64) * (DM / 32), I_QKV = (DM / 64) * (NQKV / 32), I_GU = (DM / 64) * (FF / 32), I_D = (FF / 64) * (DM / 32);
    const int j = L >> 1; const bool att = (L & 1) != 0;
    const int NITEMS = (att ? I_QKV : I_WIN) + I_SQ + 2 * I_GU + I_D;
#define P0_FOR_ITEM(it_, OP) do { int r = (it_); \
        if (!att) { if (r < I_WIN) { OP(1, 3 * DM, DM, in[2] + (size_t)j * DM * 3 * DM, in[11] + (2 * j) * DM, (bf16*)(ws + WS_WIN + j * SZ_WIN), r); break; } r -= I_WIN; \
                    if (r < I_SQ) { OP(0, DM, DM, in[4] + (size_t)j * DM * DM, (const float*)nullptr, (bf16*)(ws + WS_WOUT + j * SZ_WSQ), r); break; } r -= I_SQ; } \
        else      { if (r < I_QKV) { OP(2, NQKV, DM, in[5] + (size_t)j * DM * NQKV, in[11] + (2 * j + 1) * DM, (bf16*)(ws + WS_WQKV + j * SZ_WQKV), r); break; } r -= I_QKV; \
                    if (r < I_SQ) { OP(0, DM, DM, in[6] + (size_t)j * DM * DM, (const float*)nullptr, (bf16*)(ws + WS_WO + j * SZ_WSQ), r); break; } r -= I_SQ; } \
        if (r < I_GU) { OP(3, FF, DM, in[8] + (size_t)L * DM * FF, in[13] + L * DM, (bf16*)(ob + OUT_WGU + L * SZ_WGU), r); break; } r -= I_GU; \
        if (r < I_GU) { OP(4, FF, DM, in[9] + (size_t)L * DM * FF, in[13] + L * DM, (bf16*)(ob + OUT_WGU + L * SZ_WGU), r); break; } r -= I_GU; \
        OP(0, DM, FF, in[10] + (size_t)L * FF * DM, (const float*)nullptr, (bf16*)(ob + OUT_WD + L * SZ_WD), r); } while (0)
#define P0_OP_LOAD(MODE, N_, K_, W_, G_, D_, LI_) p0_load<N_>(W_, G_, LI_, lane, wnext, glnext)
#define P0_OP_STORE(MODE, N_, K_, W_, G_, D_, LI_) p0_store<MODE, N_>(wcur, glcur, K_, D_, scr, LI_, lane)
    float wcur[32], wnext[32], glcur = 1.0f, glnext = 1.0f;
    if (gw < NITEMS) { P0_FOR_ITEM(gw, P0_OP_LOAD); }
    for (int it = gw; it < NITEMS; it += NGW) {
#pragma unroll
        for (int i = 0; i < 32; ++i) wcur[i] = wnext[i];
        glcur = glnext;
        if (it + NGW < NITEMS) { P0_FOR_ITEM(it + NGW, P0_OP_LOAD); }
        P0_FOR_ITEM(it, P0_OP_STORE);
    }
#undef P0_FOR_ITEM
#undef P0_OP_LOAD
#undef P0_OP_STORE
}
__device__ __forceinline__ void p0_prologue(Frame& F, const float* const* in, unsigned char* ws, unsigned char* ob) {
    const int gw = F.vcu * NWAVES + F.wave, NGW = F.G * NWAVES;
    convert_layer(F, in, ws, ob, 0);
    { const int gt = gw * 64 + F.lane, NGT = NGW * 64; f32x4* tab = (f32x4*)(ws + WS_ROPE);
      for (int e = gt; e < SEQ * 32; e += NGT) { const int pos = e >> 5, i0 = (e & 31) * 2; float cs[4];
#pragma unroll
          for (int q = 0; q < 2; ++q) { double pw = 1.0; for (int k = 0; k < i0 + q; ++k) pw *= 1.1547819846894583;
              const float invf = 1.0f / (float)pw; const float ang = (float)pos * invf;
              const double turns = (double)ang * 0.15915494309189535; const float fr = (float)(turns - __builtin_rint(turns));
              cs[2 * q] = __builtin_amdgcn_cosf(fr); cs[2 * q + 1] = __builtin_amdgcn_sinf(fr); }
          tab[e] = (f32x4){cs[0], cs[1], cs[2], cs[3]}; } }
    norm_phase<0>(F, nullptr);
}

struct Args { const float* in[15]; float* out; unsigned char* ws; };
__global__ void __launch_bounds__(NWAVES * 64, 2) fwd_kernel(Args args) {
    extern __shared__ __attribute__((aligned(16))) unsigned char lds[];
    Frame F;
    F.lds = (LAS unsigned char*)lds;
    volatile LAS unsigned* MISC = (volatile LAS unsigned*)(F.lds + MISC_OFF);
    F.tid = threadIdx.x; F.lane = F.tid & 63; F.wave = __builtin_amdgcn_readfirstlane(F.tid >> 6);
    const int Gall = gridDim.x, bx = blockIdx.x;
    const int vcu_all = (Gall % 8 == 0) ? (bx % 8) * (Gall / 8) + bx / 8 : bx;
    const bool two = TWO_GROUPS && (Gall % 8 == 0);
    const int grp = two ? ((bx % 8) >> 2) : 0;
    const int GG = two ? Gall / 2 : Gall, nx = two ? 4 : 8;
    const int c_loc = two ? (bx / 8) * 4 + (bx % 4) : bx;
    const int vcu_loc = two ? (bx % 4) * (GG / 4) + bx / 8 : vcu_all;
    const int r0g = two ? grp * (M / 2) : 0, mrg = two ? M / 2 : M;
    unsigned char* ws = args.ws;
    gu32* ctl = (gu32*)(ws + WS_CTL);
    F.xp = args.in[0]; F.xs = args.in[1]; F.out = args.out; F.rs = (float*)(ws + WS_RS); F.X = (bf16*)(ws + WS_X); F.Y = (bf16*)(ws + WS_Y); F.R = (bf16*)(ws + WS_R);
    unsigned char* const ob = (unsigned char*)args.out;
    for (int u = F.tid; u < (LDS_BYTES - LDSCTL_OFF) / 4; u += NWAVES * 64) ((LAS unsigned*)(F.lds + LDSCTL_OFF))[u] = 0u;
    __syncthreads();
    const XcdBarrier barAll = xcd_barrier_post((unsigned*)(ctl + CW_BAR), MISC + 8, (unsigned)Gall);
    const XcdBarrier barG = xcd_barrier_post((unsigned*)(ctl + CW_BAR) + (1 + grp) * XCD_BAR_WORDS, MISC + 10, (unsigned)GG);
    const size_t r0 = (size_t)r0g;
    bf16* const Rg = F.R + (size_t)r0g * FF;
    bf16* const Rq = Rg;
    bf16* const Rc = Rg + (size_t)mrg * DM;
    bf16* const Rk = Rc; bf16* const Rv = Rc + (size_t)mrg * 512; bf16* const Ro = Rc + (size_t)mrg * 1024;

    F.vcu = vcu_all; F.G = Gall; F.r0 = 0; F.mr = M;
    p0_prologue(F, args.in, ws, ob);
    if (!two) { for (int L = 1; L < DEPTH; ++L) convert_layer(F, args.in, ws, ob, L); }
    xcd_barrier(barAll);
    F.vcu = vcu_loc; F.G = GG; F.r0 = r0g; F.mr = mrg;
    if (two && grp == 1) {
        convert_layer(F, args.in, ws, ob, 1); convert_layer(F, args.in, ws, ob, 2);
        xcd_barrier(barG);
        if (vcu_loc == 0 && F.tid == 0) { __hip_atomic_store(ctl + CW_FLAG + 64 * 1, 1u, RLX_AGENT); __hip_atomic_store(ctl + CW_FLAG + 64 * 2, 1u, RLX_AGENT); }
    }

    for (int li = 0; li < DEPTH; ++li) {
        const int j = li >> 1;
        const bool is_attn = (li & 1) != 0;
        if (two && li >= 1 && grp == (li == 3 ? 1 : 0)) {
            if (F.tid == 0) { unsigned sp = 0; while (__hip_atomic_load(ctl + CW_FLAG + 64 * li, RLX_AGENT) == 0u) { __builtin_amdgcn_s_sleep(8); if (++sp > (1u << 22)) break; }
                __builtin_amdgcn_fence(__ATOMIC_ACQUIRE, "agent"); asm volatile("s_waitcnt vmcnt(0)" ::: "memory"); }
            __syncthreads();
        }
        if (!is_attn) {
            pg8::Gemm g{F.X + r0 * DM, (const bf16*)(ws + WS_WIN + j * SZ_WIN), mrg, 3 * DM, DM}; pg8::StaticOrder S; S.init(mrg, 3 * DM, GG, c_loc, nx);
            pg8::EpiConvIn E{Rc, Rq, F.rs + r0};
            pg8::gemm_phase<pg8::EpiConvIn, pg8::StaticOrder, true, true>(F.lds + RING_OFF, g, S, E);
        } else {
            pg8::Gemm g{F.X + r0 * DM, (const bf16*)(ws + WS_WQKV + j * SZ_WQKV), mrg, NQKV, DM}; pg8::StaticOrder S; S.init(mrg, NQKV, GG, c_loc, nx);
            pg8::EpiQKV E{Rq, (size_t)(Rk - Rq), (size_t)(Rv - Rq), (const pg8::f32x4*)(ws + WS_ROPE), F.rs + r0, 0.12751743082459868f};
            pg8::gemm_phase<pg8::EpiQKV, pg8::StaticOrder, true, true>(F.lds + RING_OFF, g, S, E);
        }
        xcd_barrier(barG);
        if (!is_attn) conv_phase(F, Rq, Rc, args.in[3] + (size_t)j * 3 * DM);
        else { const int nun = (mrg / SEQ) * 128; for (int a = vcu_loc; a < nun; a += GG) attn::attn_unit(a >> 7, (a >> 5) & 3, a & 31, Rq, Ro, Rk, Rv, args.in[7] + j * 16, F.lds + RING_OFF); }
        xcd_barrier(barG);
        {
            pg8::Gemm g{is_attn ? Ro : Rq, (const bf16*)(is_attn ? ws + WS_WO + j * SZ_WSQ : ws + WS_WOUT + j * SZ_WSQ), mrg, DM, DM}; pg8::StaticOrder S; S.init(mrg, DM, GG, c_loc, nx);
            pg8::EpiPlain E{F.Y + r0 * DM, DM};
            pg8::gemm_phase<pg8::EpiPlain, pg8::StaticOrder, true, true>(F.lds + RING_OFF, g, S, E);
        }
        xcd_barrier(barG);
        norm_phase<1>(F, args.in[12] + li * DM);
        xcd_barrier(barG);
        {
            pg8::Gemm g{F.X + r0 * DM, (const bf16*)(ob + OUT_WGU + li * SZ_WGU), mrg, 2 * FF, DM}; pg8::StaticOrder S; S.init(mrg, 2 * FF, GG, c_loc, nx);
            pg8::EpiSwiGLU E{Rg, FF, F.rs + r0};
            pg8::gemm_phase<pg8::EpiSwiGLU, pg8::StaticOrder, true, true>(F.lds + RING_OFF, g, S, E);
        }
        xcd_barrier(barG);
        {
            pg8::Gemm g{Rg, (const bf16*)(ob + OUT_WD + li * SZ_WD), mrg, DM, FF}; pg8::StaticOrder S; S.init(mrg, DM, GG, c_loc, nx);
            pg8::EpiPlain E{F.Y + r0 * DM, DM};
            pg8::gemm_phase<pg8::EpiPlain, pg8::StaticOrder, true, true>(F.lds + RING_OFF, g, S, E);
        }
        if (li + 1 < DEPTH) { xcd_barrier(barG); norm_phase<1>(F, args.in[14] + li * DM);
            const bool cv = two && grp == 0 && li == 0;
            if (cv) convert_layer(F, args.in, ws, ob, 3);
            xcd_barrier(barG);
            if (cv && vcu_loc == 0 && F.tid == 0) __hip_atomic_store(ctl + CW_FLAG + 64 * 3, 1u, RLX_AGENT); }
        else { xcd_barrier(barAll); norm_phase<2>(F, args.in[14] + li * DM); }
    }
}

extern "C" void kernel_launch(void* const* d_in, const int* in_sizes, int n_in, void* d_out, int out_size, void* d_ws, size_t ws_size, hipStream_t stream) {
    static int grid = 0;
    if (grid == 0) {
        if (n_in != 15 || out_size != M * DM || ws_size < WS_END) { fprintf(stderr, "kernel_launch: unexpected shapes (n_in %d, out %d, ws %zu < %zu); nothing launched\n", n_in, out_size, ws_size, (size_t)WS_END); grid = -1; return; }
        int dev = 0, cus = 0, per_cu = 0;
        if (hipGetDevice(&dev) != hipSuccess || hipDeviceGetAttribute(&cus, hipDeviceAttributeMultiprocessorCount, dev) != hipSuccess) { grid = -1; return; }
        if (hipFuncSetAttribute((const void*)fwd_kernel, hipFuncAttributeMaxDynamicSharedMemorySize, LDS_BYTES) != hipSuccess) { fprintf(stderr, "kernel_launch: hipFuncSetAttribute failed\n"); grid = -1; return; }
        if (hipOccupancyMaxActiveBlocksPerMultiprocessor(&per_cu, (const void*)fwd_kernel, NWAVES * 64, LDS_BYTES) != hipSuccess || per_cu < 1) { fprintf(stderr, "kernel_launch: occupancy query says %d blocks per CU\n", per_cu); }
        (void)hipGetLastError();
        grid = cus;
    }
    if (grid < 0) return;
    if (hipMemsetAsync((char*)d_ws + WS_CTL, 0, CTL_ZERO_BYTES, stream) != hipSuccess) return;
    Args a{};
    for (int i = 0; i < 15; ++i) a.in[i] = (const float*)d_in[i];
    a.out = (float*)d_out; a.ws = (unsigned char*)d_ws;
    hipLaunchKernelGGL(fwd_kernel, dim3(grid), dim3(NWAVES * 64), LDS_BYTES, stream, a);
}
```

```cpp
#include <hip/hip_runtime.h>
#include <cstdio>
#include <cstdint>
#ifndef PROBE_EPI2
#define PROBE_EPI2 0
#endif
namespace pg8 {
#define PG8_LAS __attribute__((address_space(3)))
typedef unsigned short bf16_t;
typedef short bf16x8 __attribute__((ext_vector_type(8)));
typedef float f32x4 __attribute__((ext_vector_type(4)));
typedef unsigned u32x4 __attribute__((ext_vector_type(4)));
constexpr int BM = 256, BK = 64, HALF = 128, HTB = HALF * BK * 2  , STAGE_BYTES = 8 * HTB, NXCD = 8, WGM = 8;

__host__ __device__ __forceinline__ int lds_byte(int r, int c) { const int st = (r >> 4) * 2 + (c >> 5), rr = r & 15, cc = c & 31, ob = rr * 64 + cc * 2; return st * 1024 + (ob ^ (((ob >> 9) & 1) << 5)); }
__host__ __device__ __forceinline__ void stage_rc(int b, int& R, int& C) { const int st = b / 1024, sb = b % 1024, swz = sb ^ (((sb >> 9) & 1) << 5); R = (st >> 1) * 16 + swz / 64; C = (st & 1) * 32 + (swz % 64) / 2; }
__host__ __device__ __forceinline__ int perm32(int rho) { const int n = rho >> 4, i = rho & 15; return 8 * (i >> 2) + 4 * n + (i & 3); }

struct Unit { int pm, pn; };
struct Gemm { const bf16_t* A; const bf16_t* Bt; int M, N, K; };

struct StaticOrder {
    int nM, nN, nwg, G, c, nx;
    __host__ __device__ void init(int M, int N, int G_, int c_, int nx_ = NXCD) { nM = M / BM; nN = N / BM; nwg = nM * nN; G = G_; c = c_; nx = nx_; }
    __host__ __device__ bool next(int i, Unit& u) const {
        const long L = (long)i * G + c; if (L >= nwg) return false;
        int wgid = (int)L; { const int q = nwg / nx, r = nwg % nx, xcd = wgid % nx, off = wgid / nx; wgid = (xcd < r ? xcd * (q + 1) : r * (q + 1) + (xcd - r) * q) + off; }
        const int nig = WGM * nN, gid = wgid / nig, fm = gid * WGM, gsz = (nM - fm) < WGM ? (nM - fm) : WGM;
        u.pm = fm + ((wgid % nig) % gsz); u.pn = (wgid % nig) / gsz; return true;
    }
    __device__ __forceinline__ void a_ready(const Unit&) const {}
    __device__ __forceinline__ void done(const Unit&) const {}
};
__device__ __forceinline__ unsigned cvt_pk_bf16(float lo, float hi) { unsigned r; asm volatile("v_cvt_pk_bf16_f32 %0, %1, %2" : "=v"(r) : "v"(lo), "v"(hi)); return r; }
__device__ __forceinline__ u32x4 pack8(const f32x4& v0, const f32x4& v1) { u32x4 w; w.x = cvt_pk_bf16(v0[0], v0[1]); w.y = cvt_pk_bf16(v0[2], v0[3]); w.z = cvt_pk_bf16(v1[0], v1[1]); w.w = cvt_pk_bf16(v1[2], v1[3]); return w; }

struct EpiPlain {
    static constexpr bool PERM = true, AFTER_DRAIN = false;
    bf16_t* O; int ldc;
    __device__ __forceinline__ void operator()(const f32x4 (&acc)[2][2][4][2], const Unit& u, int wr, int wc, int fr, int fq) const {
        const int row0 = u.pm * BM + wr * 64 + fr, col0 = u.pn * BM + wc * 32 + 8 * fq;
#pragma unroll
        for (int ai = 0; ai < 2; ++ai)
#pragma unroll
            for (int m = 0; m < 4; ++m) { bf16_t* rowp = O + (size_t)(row0 + ai * HALF + m * 16) * ldc + col0;
#pragma unroll
                for (int bj = 0; bj < 2; ++bj) *(u32x4*)(rowp + bj * HALF) = pack8(acc[ai][bj][m][0], acc[ai][bj][m][1]); }
    }
};
struct EpiConvIn {
    static constexpr bool PERM = true, AFTER_DRAIN = false;
    bf16_t* U; bf16_t* Bb; const float* rs;
    __device__ __forceinline__ void operator()(const f32x4 (&acc)[2][2][4][2], const Unit& u, int wr, int wc, int fr, int fq) const {
        const int row0 = u.pm * BM + wr * 64 + fr;
        float sv[2][4];
#pragma unroll
        for (int ai = 0; ai < 2; ++ai)
#pragma unroll
            for (int m = 0; m < 4; ++m) sv[ai][m] = rs[row0 + ai * HALF + m * 16];
        __builtin_amdgcn_sched_barrier(0);
        if (u.pn < 16) {
            const int col0 = u.pn * 128 + wc * 32 + 8 * fq;
#pragma unroll
            for (int ai = 0; ai < 2; ++ai)
#pragma unroll
                for (int m = 0; m < 4; ++m) { const int row = row0 + ai * HALF + m * 16; bf16_t* rowp = U + (size_t)row * 2048 + col0; const float s = sv[ai][m], s2 = s * s;
                    *(u32x4*)rowp = pack8(acc[ai][0][m][0] * acc[ai][1][m][0] * s2, acc[ai][0][m][1] * acc[ai][1][m][1] * s2); }
        } else {
            const int col0 = (u.pn - 16) * BM + wc * 32 + 8 * fq;
#pragma unroll
            for (int ai = 0; ai < 2; ++ai)
#pragma unroll
                for (int m = 0; m < 4; ++m) { const int row = row0 + ai * HALF + m * 16; bf16_t* rowp = Bb + (size_t)row * 2048 + col0; const float s = sv[ai][m];
#pragma unroll
                    for (int bj = 0; bj < 2; ++bj) *(u32x4*)(rowp + bj * HALF) = pack8(acc[ai][bj][m][0] * s, acc[ai][bj][m][1] * s); }
        }
    }
};
struct EpiSwiGLU {
    static constexpr bool PERM = true, AFTER_DRAIN = false;
    bf16_t* O; int ldc; const float* rs;
    typedef float f32x2 __attribute__((ext_vector_type(2)));
    static __device__ __forceinline__ f32x2 silu_mul2(f32x2 g, f32x2 up, float sneg, float s2) {
        const f32x2 t = g * sneg; f32x2 e; e.x = __builtin_amdgcn_exp2f(t.x); e.y = __builtin_amdgcn_exp2f(t.y);
        const f32x2 d = e + 1.0f; f32x2 r; r.x = __builtin_amdgcn_rcpf(d.x); r.y = __builtin_amdgcn_rcpf(d.y);
        return (g * up) * (r * s2);
    }
    __device__ __forceinline__ void operator()(const f32x4 (&acc)[2][2][4][2], const Unit& u, int wr, int wc, int fr, int fq) const {
        const int row0 = u.pm * BM + wr * 64 + fr, col0 = u.pn * 128 + wc * 32 + 8 * fq;
        float sv[2][4];
#pragma unroll
        for (int ai = 0; ai < 2; ++ai)
#pragma unroll
            for (int m = 0; m < 4; ++m) sv[ai][m] = rs[row0 + ai * HALF + m * 16];
        __builtin_amdgcn_sched_barrier(0);
#pragma unroll
        for (int ai = 0; ai < 2; ++ai)
#pragma unroll
            for (int m = 0; m < 4; ++m) { const int row = row0 + ai * HALF + m * 16; bf16_t* rowp = O + (size_t)row * ldc + col0; const float s = sv[ai][m], sneg = s * -1.44269504089f, s2 = s * s;
                const f32x4 g0 = acc[ai][0][m][0], g1 = acc[ai][0][m][1], u0 = acc[ai][1][m][0], u1 = acc[ai][1][m][1];
                const f32x2 a = silu_mul2((f32x2){g0[0], g0[1]}, (f32x2){u0[0], u0[1]}, sneg, s2), b = silu_mul2((f32x2){g0[2], g0[3]}, (f32x2){u0[2], u0[3]}, sneg, s2);
                const f32x2 c = silu_mul2((f32x2){g1[0], g1[1]}, (f32x2){u1[0], u1[1]}, sneg, s2), d = silu_mul2((f32x2){g1[2], g1[3]}, (f32x2){u1[2], u1[3]}, sneg, s2);
                *(u32x4*)rowp = pack8((f32x4){a.x, a.y, b.x, b.y}, (f32x4){c.x, c.y, d.x, d.y}); }
    }
};
struct EpiQKV {
    static constexpr bool PERM = true, AFTER_DRAIN = false;
    bf16_t* Q; size_t koff, voff; const f32x4* rope; const float* rs; float qscale;
    __device__ __forceinline__ void operator()(const f32x4 (&acc)[2][2][4][2], const Unit& u, int wr, int wc, int fr, int fq) const {
        const int row0 = u.pm * BM + wr * 64 + fr;
        const int kind = u.pn < 8 ? 0 : (u.pn < 10 ? 1 : 2);
        bf16_t* base = Q + (size_t)(kind >= 1) * koff + (size_t)(kind == 2) * (voff - koff);
        const int ldc = 2048 - 1536 * (kind >= 1);
        const int colt = (u.pn - 8 * (kind >= 1) - 2 * (kind == 2)) * BM;
        const int col0 = colt + wc * 32 + 8 * fq;
        const float sc0 = kind == 0 ? qscale : 1.0f;
        float sv[2][4];
#pragma unroll
        for (int ai = 0; ai < 2; ++ai)
#pragma unroll
            for (int m = 0; m < 4; ++m) sv[ai][m] = rs[row0 + ai * HALF + m * 16];
#pragma unroll
        for (int ai = 0; ai < 2; ++ai) {
            f32x4 csv[4][2];
#pragma unroll
            for (int m = 0; m < 4; ++m) { const int row = row0 + ai * HALF + m * 16; const f32x4* rp = rope + (size_t)(row & 2047) * 32 + 8 * wc + 2 * fq; csv[m][0] = rp[0]; csv[m][1] = rp[1]; }
            __builtin_amdgcn_sched_barrier(0);
#pragma unroll
            for (int m = 0; m < 4; ++m) { const int row = row0 + ai * HALF + m * 16; bf16_t* rowp = base + (size_t)row * ldc + col0; const float sc = sc0 * sv[ai][m];
                f32x4 cs0 = (f32x4){1.f, 0.f, 1.f, 0.f}, cs1 = (f32x4){1.f, 0.f, 1.f, 0.f};
                if (kind != 2) { cs0 = csv[m][0]; cs1 = csv[m][1]; }
#pragma unroll
                for (int bj = 0; bj < 2; ++bj) { const f32x4 a0 = acc[ai][bj][m][0], a1 = acc[ai][bj][m][1]; f32x4 v0, v1;
                    v0[0] = (a0[0] * cs0[0] - a0[1] * cs0[1]) * sc; v0[1] = (a0[1] * cs0[0] + a0[0] * cs0[1]) * sc;
                    v0[2] = (a0[2] * cs0[2] - a0[3] * cs0[3]) * sc; v0[3] = (a0[3] * cs0[2] + a0[2] * cs0[3]) * sc;
                    v1[0] = (a1[0] * cs1[0] - a1[1] * cs1[1]) * sc; v1[1] = (a1[1] * cs1[0] + a1[0] * cs1[1]) * sc;
                    v1[2] = (a1[2] * cs1[2] - a1[3] * cs1[3]) * sc; v1[3] = (a1[3] * cs1[2] + a1[2] * cs1[3]) * sc;
                    *(u32x4*)(rowp + bj * HALF) = pack8(v0, v1); } }
        }
    }
};

template <class Epi, class Sched, bool ALIGN_EPI = false, bool SP2 = false>
__device__ __forceinline__ void gemm_phase(PG8_LAS unsigned char* lds, const Gemm g, const Sched& S, const Epi& E) {
    int tid_ = threadIdx.x, K_ = g.K; asm volatile("" : "+v"(tid_)); asm volatile("" : "+s"(K_));
    const int tid = tid_, wid = __builtin_amdgcn_readfirstlane(tid >> 6), lane = tid & 63, wr = wid >> 2, wc = wid & 3, fr = lane & 15, fq = lane >> 4;
    const int K = K_, nt = K / BK; __builtin_assume(nt >= 4 && (nt & 1) == 0);
    unsigned voffA[2], voffB[2];
#pragma unroll
    for (int i = 0; i < 2; ++i) { int R, C; stage_rc(tid * 16 + i * 8192, R, C); const int Rb = Epi::PERM ? ((R & ~31) + perm32(R & 31)) : R;
        voffA[i] = (unsigned)(R * K + C) * 2u; voffB[i] = (unsigned)(Rb * K + C) * 2u; }
    const size_t kstep = (size_t)(BK * 2);
    const size_t hstep = (size_t)HALF * K * 2;
    const size_t tstep = 2 * hstep;
    const unsigned ldsw = (unsigned)wid * 1024u;
    const int aoff = lds_byte(wr * 64 + fr, fq * 8), boff = lds_byte(wc * 32 + fr, fq * 8);
#define PG8_SA(b, h) (((b) * 2 + (h)) * HTB)
#define PG8_SB(b, h) ((4 + (b) * 2 + (h)) * HTB)
#define PG8_STAGE(bufoff, gbase, voff) do { _Pragma("unroll") for (int _i = 0; _i < 2; ++_i) \
        __builtin_amdgcn_global_load_lds((const unsigned*)((const char*)(gbase) + (voff)[_i]), (PG8_LAS unsigned*)(lds + (bufoff) + ldsw + _i * 8192), 16, 0, 0); } while (0)
#define PG8_LDA(dst, b, h) do { _Pragma("unroll") for (int m = 0; m < 4; ++m) _Pragma("unroll") for (int k = 0; k < 2; ++k) dst[m][k] = *(const PG8_LAS bf16x8*)(lds + PG8_SA(b, h) + aoff + m * 2048 + k * 1024); } while (0)
#define PG8_LDB(dst, b, h) do { _Pragma("unroll") for (int n = 0; n < 2; ++n) _Pragma("unroll") for (int k = 0; k < 2; ++k) dst[n][k] = *(const PG8_LAS bf16x8*)(lds + PG8_SB(b, h) + boff + n * 2048 + k * 1024); } while (0)
#define PG8_MMA(ai, bj, At, Bt) do { __builtin_amdgcn_s_setprio(1); _Pragma("unroll") for (int m = 0; m < 4; ++m) _Pragma("unroll") for (int n = 0; n < 2; ++n) _Pragma("unroll") for (int k = 0; k < 2; ++k) \
        acc[ai][bj][m][n] = __builtin_amdgcn_mfma_f32_16x16x32_bf16(Bt[n][k], At[m][k], acc[ai][bj][m][n], 0, 0, 0); __builtin_amdgcn_s_setprio(0); } while (0)
#define PG8_WAIT_V(n) asm volatile("s_waitcnt vmcnt(" #n ")" ::: "memory")
#define PG8_WAIT_L(n) asm volatile("s_waitcnt lgkmcnt(" #n ")" ::: "memory")
#define PG8_BAR __builtin_amdgcn_s_barrier()
#define PG8_SCHED __builtin_amdgcn_sched_barrier(0)
    Unit cur, nxt; int ui = 0;
    if (!S.next(0, cur)) return;
    long ksc = (long)kstep, ksn = (long)kstep;
    const size_t kend = (size_t)(nt - 1) * kstep;
    f32x4 acc[2][2][4][2];
#pragma unroll
    for (int a = 0; a < 2; ++a)
#pragma unroll
        for (int b = 0; b < 2; ++b)
#pragma unroll
            for (int m = 0; m < 4; ++m)
#pragma unroll
                for (int n = 0; n < 2; ++n) acc[a][b][m][n] = (f32x4){0.f, 0.f, 0.f, 0.f};
    bf16x8 At[4][2], B0[2][2], B1[2][2];
    const char* cA = (const char*)g.A + (size_t)cur.pm * tstep; const char* cB = (const char*)g.Bt + (size_t)cur.pn * tstep;
    S.a_ready(cur);
    if constexpr (SP2) {
        PG8_STAGE(PG8_SB(0, 0), cB, voffB); PG8_STAGE(PG8_SB(0, 1), cB + hstep, voffB); PG8_STAGE(PG8_SA(0, 0), cA, voffA); PG8_STAGE(PG8_SA(0, 1), cA + hstep, voffA);
        if (wr == 1) PG8_BAR;
        PG8_WAIT_V(2); PG8_BAR;
        PG8_STAGE(PG8_SB(1, 0), cB + kstep, voffB); PG8_STAGE(PG8_SA(1, 0), cA + kstep, voffA); PG8_STAGE(PG8_SB(1, 1), cB + hstep + kstep, voffB);
        PG8_WAIT_V(6); PG8_BAR;
    } else {
        PG8_STAGE(PG8_SB(0, 0), cB, voffB); PG8_STAGE(PG8_SA(0, 0), cA, voffA); PG8_STAGE(PG8_SB(0, 1), cB + hstep, voffB); PG8_STAGE(PG8_SA(0, 1), cA + hstep, voffA);
        if (wr == 1) PG8_BAR;
        PG8_WAIT_V(4); PG8_BAR;
        PG8_STAGE(PG8_SB(1, 0), cB + kstep, voffB); PG8_STAGE(PG8_SA(1, 0), cA + kstep, voffA); PG8_STAGE(PG8_SB(1, 1), cB + hstep + kstep, voffB);
        PG8_WAIT_V(6); PG8_BAR;
    }
    for (;;) {
        const bool has_next = S.next(ui + 1, nxt);
        const bool nrev = has_next && ((ui + 1) & 1);
        const char* nA = has_next ? (const char*)g.A + (size_t)nxt.pm * tstep + (nrev ? kend : 0) : cA; const char* nB = has_next ? (const char*)g.Bt + (size_t)nxt.pn * tstep + (nrev ? kend : 0) : cB;
        ksn = has_next ? (nrev ? -(long)kstep : (long)kstep) : ksc;
        for (int t = 0; t < nt; t += 2) {
            const bool last = (t == nt - 2);
            const char* a1 = cA + (long)(t + 1) * ksc;
            const char* a2 = last ? nA : cA + (long)(t + 2) * ksc; const char* b2 = last ? nB : cB + (long)(t + 2) * ksc;
            const long ks3 = last ? ksn : ksc;
            const char* a3 = a2 + ks3; const char* b3 = b2 + ks3;
            if (last && has_next) S.a_ready(nxt);
            if constexpr (SP2) {
            PG8_LDB(B0, 0, 0); PG8_LDB(B1, 0, 1); PG8_SCHED; PG8_LDA(At, 0, 0); PG8_STAGE(PG8_SA(1, 1), a1 + hstep, voffA);
            PG8_WAIT_V(8); PG8_WAIT_L(0); PG8_BAR; PG8_MMA(0, 0, At, B0); PG8_MMA(0, 1, At, B1); PG8_BAR; PG8_SCHED;
            PG8_LDA(At, 0, 1); PG8_STAGE(PG8_SB(0, 0), b2, voffB); PG8_STAGE(PG8_SB(0, 1), b2 + hstep, voffB); PG8_STAGE(PG8_SA(0, 0), a2, voffA);
            PG8_WAIT_V(8); PG8_WAIT_L(0); PG8_BAR; PG8_MMA(1, 0, At, B0); PG8_MMA(1, 1, At, B1); PG8_BAR; PG8_SCHED;
            PG8_LDB(B0, 1, 0); PG8_LDB(B1, 1, 1); PG8_SCHED; PG8_LDA(At, 1, 0); PG8_STAGE(PG8_SA(0, 1), a2 + hstep, voffA);
            PG8_WAIT_V(8); PG8_WAIT_L(0); PG8_BAR; PG8_MMA(0, 0, At, B0); PG8_MMA(0, 1, At, B1); PG8_BAR; PG8_SCHED;
            PG8_LDA(At, 1, 1); PG8_STAGE(PG8_SB(1, 0), b3, voffB); PG8_STAGE(PG8_SB(1, 1), b3 + hstep, voffB); PG8_STAGE(PG8_SA(1, 0), a3, voffA);
            PG8_WAIT_V(8); PG8_WAIT_L(0); PG8_BAR; PG8_MMA(1, 0, At, B0); PG8_MMA(1, 1, At, B1); PG8_BAR; PG8_SCHED;
            } else {
            PG8_LDB(B0, 0, 0); PG8_SCHED; PG8_LDA(At, 0, 0); PG8_STAGE(PG8_SA(1, 1), a1 + hstep, voffA);
            PG8_WAIT_L(8); PG8_BAR; PG8_WAIT_L(0); PG8_MMA(0, 0, At, B0); PG8_BAR; PG8_SCHED;
            PG8_LDB(B1, 0, 1); PG8_STAGE(PG8_SB(0, 0), b2, voffB);
            PG8_BAR; PG8_WAIT_L(0); PG8_MMA(0, 1, At, B1); PG8_BAR;
            PG8_LDA(At, 0, 1); PG8_STAGE(PG8_SA(0, 0), a2, voffA);
            PG8_BAR; PG8_WAIT_L(0); PG8_MMA(1, 0, At, B0); PG8_BAR; PG8_SCHED;
            PG8_STAGE(PG8_SB(0, 1), b2 + hstep, voffB);
            PG8_WAIT_V(6); PG8_BAR; PG8_MMA(1, 1, At, B1); PG8_BAR;
            PG8_LDB(B0, 1, 0); PG8_SCHED; PG8_LDA(At, 1, 0); PG8_STAGE(PG8_SA(0, 1), a2 + hstep, voffA);
            PG8_WAIT_L(8); PG8_BAR; PG8_WAIT_L(0); PG8_MMA(0, 0, At, B0); PG8_BAR; PG8_SCHED;
            PG8_LDB(B1, 1, 1); PG8_STAGE(PG8_SB(1, 0), b3, voffB);
            PG8_BAR; PG8_WAIT_L(0); PG8_MMA(0, 1, At, B1); PG8_BAR;
            PG8_LDA(At, 1, 1); PG8_STAGE(PG8_SA(1, 0), a3, voffA);
            PG8_BAR; PG8_WAIT_L(0); PG8_MMA(1, 0, At, B0); PG8_BAR; PG8_SCHED;
            PG8_STAGE(PG8_SB(1, 1), b3 + hstep, voffB);
            PG8_WAIT_V(6); PG8_BAR; PG8_MMA(1, 1, At, B1); PG8_BAR;
            }
        }
        if constexpr (ALIGN_EPI) { if (wr == 0) PG8_BAR; }
        if constexpr (!Epi::AFTER_DRAIN) { E(acc, cur, wr, wc, fr, fq);
#if PROBE_EPI2
            asm volatile("" ::: "memory"); E(acc, cur, wr, wc, fr, fq);
#endif
            S.done(cur); }
        if (!has_next) break;
#pragma unroll
        for (int a = 0; a < 2; ++a)
#pragma unroll
            for (int b = 0; b < 2; ++b)
#pragma unroll
                for (int m = 0; m < 4; ++m)
#pragma unroll
                    for (int n = 0; n < 2; ++n) acc[a][b][m][n] = (f32x4){0.f, 0.f, 0.f, 0.f};
        cur = nxt; cA = nA; cB = nB; ksc = ksn; ++ui;
        if constexpr (ALIGN_EPI) { if (wr == 1) PG8_BAR; }
    }
    PG8_WAIT_V(0);
    if constexpr (!ALIGN_EPI) { if (wr == 0) PG8_BAR; }
    PG8_BAR;
    if constexpr (Epi::AFTER_DRAIN) { E.fused(acc, cur, wr, wc, fr, fq, lds, wid, lane); S.done(cur); }
#undef PG8_SA
#undef PG8_SB
#undef PG8_STAGE
#undef PG8_LDA
#undef PG8_LDB
#undef PG8_MMA
#undef PG8_WAIT_V
#undef PG8_WAIT_L
#undef PG8_BAR
#undef PG8_SCHED
}
}
namespace attn {
#define ATT_LAS __attribute__((address_space(3)))
typedef unsigned short bf16;
typedef short bf16x8 __attribute__((ext_vector_type(8)));
typedef short s16x4 __attribute__((ext_vector_type(4)));
typedef float f32x16 __attribute__((ext_vector_type(16)));
typedef unsigned u32x4 __attribute__((ext_vector_type(4)));
typedef unsigned u32x2 __attribute__((ext_vector_type(2)));
constexpr int SEQ = 2048, DMODEL = 2048, KVW = 512, HD = 128, CHUNK = 64, CHUNK_BYTES = CHUNK * HD * 2;
constexpr int NSLOT = 4, ATT_LDS_BYTES = 2 * NSLOT * CHUNK_BYTES;
constexpr int NUNITS = 20 * 4 * 32;
__device__ __forceinline__ unsigned off_b(unsigned row, unsigned ch) { return 256u * row + 16u * (ch ^ (((row & 3) << 2) | ((row >> 2) & 3))); }
__device__ __forceinline__ unsigned tr_read_addr(unsigned lane, unsigned c, unsigned ks, unsigned t) {
    const unsigned h = lane >> 5, blk = (lane >> 4) & 1, q = (lane & 15) >> 2, p = lane & 3;
    return off_b(16 * ks + 8 * h + 4 * t + q, 4 * c + 2 * blk + (p >> 1)) + 8 * (p & 1);
}
__device__ __forceinline__ unsigned cvt_pk(float lo, float hi) { unsigned r; asm volatile("v_cvt_pk_bf16_f32 %0, %1, %2" : "=v"(r) : "v"(lo), "v"(hi)); return r; }
__device__ __forceinline__ s16x4 vtr(const ATT_LAS unsigned char* p) { typedef short v4i16_t __attribute__((ext_vector_type(4))); return __builtin_bit_cast(s16x4, __builtin_amdgcn_ds_read_tr16_b64_v4i16((ATT_LAS v4i16_t*)p)); }

__device__ __forceinline__ void attn_unit(int b, int kh, int qb, const bf16* __restrict__ Qg, bf16* __restrict__ Og, const bf16* __restrict__ Kg, const bf16* __restrict__ Vg, const float* __restrict__ sink, ATT_LAS unsigned char* lds) {
    int tid_ = threadIdx.x; asm volatile("" : "+v"(tid_));
    const int tid = tid_, wid = __builtin_amdgcn_readfirstlane(tid >> 6), lane = tid & 63, r = lane & 31, h = lane >> 5;
    const int g = wid & 3, sub = wid >> 2, head = kh * 4 + g;
    const int qpos0 = qb * 64 + sub * 32;
    const size_t rowbase = (size_t)b * SEQ;
    const bf16* qrow = Qg + (rowbase + qpos0 + r) * DMODEL + head * HD; bf16* orow = Og + (rowbase + qpos0 + r) * DMODEL + head * HD;
    bf16x8 qf[8];
#pragma unroll
    for (int s = 0; s < 8; ++s) qf[s] = *(const bf16x8*)(qrow + 16 * s + 8 * h);
    float m_run = sink[head] * 1.44269504089f, l_run = (h == 0) ? 1.0f : 0.0f;
    f32x16 o[4];
#pragma unroll
    for (int c = 0; c < 4; ++c)
#pragma unroll
        for (int i = 0; i < 16; ++i) o[c][i] = 0.f;
    const int kc_first = qb * 64 - 128;
    const int c_lo = kc_first < 0 ? (-kc_first) / 64 : 0;
    int c_hi = 4; while (kc_first + 64 * c_hi >= SEQ) --c_hi;
    const bf16* kg[2]; const bf16* vg[2];
#pragma unroll
    for (int i = 0; i < 2; ++i) { const int srow = 4 * (2 * wid + i) + (lane >> 4), pos = lane & 15, sch = pos ^ (((srow & 3) << 2) | ((srow >> 2) & 3));
        const size_t eo = (rowbase + (size_t)(kc_first + srow)) * KVW + kh * HD + sch * 8; kg[i] = Kg + eo; vg[i] = Vg + eo; }
#define ATT_STAGE(c, buf) do { _Pragma("unroll") for (int _i = 0; _i < 2; ++_i) { \
        __builtin_amdgcn_global_load_lds((const unsigned*)(kg[_i] + (size_t)(64 * (c)) * KVW), (ATT_LAS unsigned*)(lds + (buf) * CHUNK_BYTES + (2 * wid + _i) * 1024), 16, 0, 0); \
        __builtin_amdgcn_global_load_lds((const unsigned*)(vg[_i] + (size_t)(64 * (c)) * KVW), (ATT_LAS unsigned*)(lds + (NSLOT + (buf)) * CHUNK_BYTES + (2 * wid + _i) * 1024), 16, 0, 0); } } while (0)
    const int rp = (r & 0x13) | ((r & 4) << 1) | ((r & 8) >> 1);
    const unsigned kbase0 = 256u * rp + 16u * ((unsigned)h ^ (((rp & 3) << 2) | ((rp >> 2) & 3)));
    unsigned vbase0[2];
    { const unsigned blk = (lane >> 4) & 1, q = (lane & 15) >> 2, p = lane & 3;
#pragma unroll
      for (int t = 0; t < 2; ++t) vbase0[t] = 2048u * h + 1024u * t + 256u * q + 64u * q + 16u * ((2 * blk + (p >> 1)) ^ (2 * h + t)) + 8u * (p & 1); }
    asm volatile("s_waitcnt lgkmcnt(0)" ::: "memory"); __builtin_amdgcn_s_barrier(); asm volatile("" ::: "memory");
#pragma unroll
    for (int j = 0; j < NSLOT - 1; ++j) if (c_lo + j <= c_hi) ATT_STAGE(c_lo + j, j);
    for (int c = c_lo; c <= c_hi; ++c) {
        const int idx = c - c_lo, cur = idx & (NSLOT - 1), ahead = (c_hi - c) < (NSLOT - 2) ? (c_hi - c) : (NSLOT - 2);
        if (ahead >= 2) asm volatile("s_waitcnt vmcnt(8)" ::: "memory"); else if (ahead == 1) asm volatile("s_waitcnt vmcnt(4)" ::: "memory"); else asm volatile("s_waitcnt vmcnt(0)" ::: "memory");
        asm volatile("s_waitcnt lgkmcnt(0)" ::: "memory"); __builtin_amdgcn_s_barrier(); asm volatile("" ::: "memory");
        if (c + NSLOT - 1 <= c_hi) ATT_STAGE(c + NSLOT - 1, (idx + NSLOT - 1) & (NSLOT - 1));
        unsigned kbase = kbase0, vbase[2] = {vbase0[0], vbase0[1]}; asm volatile("" : "+v"(kbase), "+v"(vbase[0]), "+v"(vbase[1]));
        const ATT_LAS unsigned char* kb = lds + cur * CHUNK_BYTES; const ATT_LAS unsigned char* vb = lds + (NSLOT + cur) * CHUNK_BYTES;
        const int d00 = kc_first + 64 * c - qpos0, d01 = d00 + 32;
        const bool n0 = (d00 >= -128 && d00 <= 128), n1 = (d01 >= -128 && d01 <= 128);
        if (n0 || n1) {
            f32x16 s0, s1;
#pragma unroll
            for (int i = 0; i < 16; ++i) { s0[i] = n0 ? -m_run : -1e30f; s1[i] = n1 ? -m_run : -1e30f; }
            if (n0) { bf16x8 ka[8];
#pragma unroll
                for (int ks = 0; ks < 8; ++ks) ka[ks] = *(const ATT_LAS bf16x8*)(kb + (kbase ^ (32u * ks)));
                __builtin_amdgcn_sched_barrier(0);
#pragma unroll
                for (int ks = 0; ks < 8; ++ks) s0 = __builtin_amdgcn_mfma_f32_32x32x16_bf16(ka[ks], qf[ks], s0, 0, 0, 0); }
            if (n1) { bf16x8 ka[8];
#pragma unroll
                for (int ks = 0; ks < 8; ++ks) ka[ks] = *(const ATT_LAS bf16x8*)(kb + 8192 + (kbase ^ (32u * ks)));
                __builtin_amdgcn_sched_barrier(0);
#pragma unroll
                for (int ks = 0; ks < 8; ++ks) s1 = __builtin_amdgcn_mfma_f32_32x32x16_bf16(ka[ks], qf[ks], s1, 0, 0, 0); }
            s16x4 va[16];
            { const int t = n0 ? 0 : 1;
#pragma unroll
              for (int cc = 0; cc < 4; ++cc)
#pragma unroll
                  for (int ks = 0; ks < 2; ++ks) { va[4 * cc + 2 * ks] = vtr(vb + t * 8192 + 4096 * ks + (vbase[0] ^ (64u * cc))); va[4 * cc + 2 * ks + 1] = vtr(vb + t * 8192 + 4096 * ks + (vbase[1] ^ (64u * cc))); } }
            if (d00 == -128 || d00 == 128) {
#pragma unroll
                for (int i = 0; i < 16; ++i) { const int a = i >> 2, e = i & 3; const int kk = e + 4 * (a & 1) + 8 * h + 16 * (a >> 1); const int dd = d00 + kk - r; if (dd > 128 || dd < -128) s0[i] = -1e30f; }
            }
            if (d01 == -128 || d01 == 128) {
#pragma unroll
                for (int i = 0; i < 16; ++i) { const int a = i >> 2, e = i & 3; const int kk = e + 4 * (a & 1) + 8 * h + 16 * (a >> 1); const int dd = d01 + kk - r; if (dd > 128 || dd < -128) s1[i] = -1e30f; }
            }
            float mt = fmaxf(s0[0], s1[0]);
#pragma unroll
            for (int i = 1; i < 16; ++i) mt = fmaxf(mt, fmaxf(s0[i], s1[i]));
            mt = fmaxf(mt, __shfl_xor(mt, 32));
            if (!__all(mt <= 8.0f)) {
                const float delta = fmaxf(mt, 0.f), alpha = __builtin_amdgcn_exp2f(-delta);
                m_run += delta; l_run *= alpha;
#pragma unroll
                for (int i = 0; i < 16; ++i) { s0[i] -= delta; s1[i] -= delta; }
#pragma unroll
                for (int cc = 0; cc < 4; ++cc)
#pragma unroll
                    for (int i = 0; i < 16; ++i) o[cc][i] *= alpha;
            }
            float ps = 0.f;
#pragma unroll
            for (int i = 0; i < 16; ++i) { s0[i] = __builtin_amdgcn_exp2f(s0[i]); s1[i] = __builtin_amdgcn_exp2f(s1[i]); ps += s0[i] + s1[i]; }
            l_run += ps;
            bf16x8 pa[2], pb[2];
#pragma unroll
            for (int ks = 0; ks < 2; ++ks) { u32x4 w; w.x = cvt_pk(s0[8 * ks + 0], s0[8 * ks + 1]); w.y = cvt_pk(s0[8 * ks + 2], s0[8 * ks + 3]); w.z = cvt_pk(s0[8 * ks + 4], s0[8 * ks + 5]); w.w = cvt_pk(s0[8 * ks + 6], s0[8 * ks + 7]); pa[ks] = __builtin_bit_cast(bf16x8, w);
                u32x4 w1; w1.x = cvt_pk(s1[8 * ks + 0], s1[8 * ks + 1]); w1.y = cvt_pk(s1[8 * ks + 2], s1[8 * ks + 3]); w1.z = cvt_pk(s1[8 * ks + 4], s1[8 * ks + 5]); w1.w = cvt_pk(s1[8 * ks + 6], s1[8 * ks + 7]); pb[ks] = __builtin_bit_cast(bf16x8, w1); }
            s16x4 vb2[16];
            if (n0 && n1) {
#pragma unroll
                for (int cc = 0; cc < 4; ++cc)
#pragma unroll
                    for (int ks = 0; ks < 2; ++ks) { vb2[4 * cc + 2 * ks] = vtr(vb + 8192 + 4096 * ks + (vbase[0] ^ (64u * cc))); vb2[4 * cc + 2 * ks + 1] = vtr(vb + 8192 + 4096 * ks + (vbase[1] ^ (64u * cc))); }
            }
            __builtin_amdgcn_sched_barrier(0);
#pragma unroll
            for (int cc = 0; cc < 4; ++cc)
#pragma unroll
                for (int ks = 0; ks < 2; ++ks) { const bf16x8 vf = __builtin_shufflevector(va[4 * cc + 2 * ks], va[4 * cc + 2 * ks + 1], 0, 1, 2, 3, 4, 5, 6, 7);
                    o[cc] = __builtin_amdgcn_mfma_f32_32x32x16_bf16(vf, n0 ? pa[ks] : pb[ks], o[cc], 0, 0, 0); }
            if (n0 && n1) {
#pragma unroll
                for (int cc = 0; cc < 4; ++cc)
#pragma unroll
                    for (int ks = 0; ks < 2; ++ks) { const bf16x8 vf = __builtin_shufflevector(vb2[4 * cc + 2 * ks], vb2[4 * cc + 2 * ks + 1], 0, 1, 2, 3, 4, 5, 6, 7);
                        o[cc] = __builtin_amdgcn_mfma_f32_32x32x16_bf16(vf, pb[ks], o[cc], 0, 0, 0); }
            }
        }
    }
    const float lt = l_run + __shfl_xor(l_run, 32), inv = 1.0f / lt;
#pragma unroll
    for (int cc = 0; cc < 4; ++cc)
#pragma unroll
        for (int a = 0; a < 4; a += 2) {
            unsigned ax = cvt_pk(o[cc][4 * a + 0] * inv, o[cc][4 * a + 1] * inv), ay = cvt_pk(o[cc][4 * a + 2] * inv, o[cc][4 * a + 3] * inv);
            unsigned bx = cvt_pk(o[cc][4 * a + 4] * inv, o[cc][4 * a + 5] * inv), by = cvt_pk(o[cc][4 * a + 6] * inv, o[cc][4 * a + 7] * inv);
            { const auto rx = __builtin_amdgcn_permlane32_swap(ax, bx, false, false); ax = rx[0]; bx = rx[1]; }
            { const auto ry = __builtin_amdgcn_permlane32_swap(ay, by, false, false); ay = ry[0]; by = ry[1]; }
            u32x4 w; w.x = ax; w.y = ay; w.z = bx; w.w = by;
            *(u32x4*)(orow + 32 * cc + 8 * a + 8 * h) = w; }
#undef ATT_STAGE
}
}

constexpr int NWAVES = 8;
constexpr int DM = 2048, FF = 5632, NQKV = 3072, SEQ = 2048, NSEQ = 20, M = NSEQ * SEQ, MP = 16 * SEQ, DEPTH = 4;
constexpr float EPS = 1e-6f;
#ifndef PROBE_P0_VALU
#define PROBE_P0_VALU 0
#endif
#ifndef TWO_GROUPS
#define TWO_GROUPS 1
#endif

constexpr size_t MiB = 1u << 20;
constexpr size_t WS_CTL = 0, CTL_ZERO_BYTES = 1 * MiB;
constexpr size_t WS_ROPE = 1 * MiB;
constexpr size_t WS_RS = 2 * MiB;
constexpr size_t WS_W = 3 * MiB;
constexpr size_t SZ_WIN = (size_t)3 * DM * DM * 2, SZ_WSQ = (size_t)DM * DM * 2, SZ_WQKV = (size_t)NQKV * DM * 2, SZ_WGU = (size_t)2 * FF * DM * 2, SZ_WD = (size_t)DM * FF * 2;
constexpr size_t WS_WIN = WS_W, WS_WOUT = WS_WIN + 2 * SZ_WIN, WS_WQKV = WS_WOUT + 2 * SZ_WSQ, WS_WO = WS_WQKV + 2 * SZ_WQKV;
constexpr size_t WS_X = WS_WO + 2 * SZ_WSQ;
constexpr size_t WS_Y = WS_X + (size_t)M * DM * 2;
constexpr size_t WS_R = WS_Y + (size_t)M * DM * 2;
constexpr size_t WS_END = WS_R + (size_t)M * FF * 2;
static_assert(WS_X == 107 * MiB && WS_END == 867 * MiB, "d_ws map");
constexpr size_t OUT_WGU = 0, OUT_WD = 4 * SZ_WGU;
static_assert(OUT_WD + 4 * SZ_WD <= (size_t)M * DM * 4, "d_out scratch map");
constexpr int CW_BAR = 4096;
constexpr int CW_FLAG = 64;

constexpr int RING_OFF = 0, RING_BYTES = 131072;
constexpr int LDSCTL_OFF = RING_BYTES, MISC_OFF = LDSCTL_OFF + 320;
constexpr int LDS_BYTES = 147456;
static_assert(MISC_OFF + 128 <= LDS_BYTES, "LDS map");
static_assert(attn::ATT_LDS_BYTES <= RING_BYTES, "attention LDS");

#define GAS __attribute__((address_space(1)))
#define LAS __attribute__((address_space(3)))
typedef unsigned short bf16;
typedef unsigned v4u __attribute__((ext_vector_type(4)));
typedef float f32x4 __attribute__((ext_vector_type(4)));
typedef GAS unsigned gu32;
#define RLX_AGENT __ATOMIC_RELAXED, __HIP_MEMORY_SCOPE_AGENT
#define LDS_WAIT() asm volatile("s_waitcnt lgkmcnt(0)" ::: "memory")
__device__ __forceinline__ unsigned f2bf(float f) { unsigned u = __builtin_bit_cast(unsigned, f); return (u + 0x7fffu + ((u >> 16) & 1u)) >> 16; }
__device__ __forceinline__ unsigned pk2(float lo, float hi) { unsigned r; asm("v_cvt_pk_bf16_f32 %0, %1, %2" : "=v"(r) : "v"(lo), "v"(hi)); return r; }
__device__ __forceinline__ float bflo(unsigned w) { return __builtin_bit_cast(float, w << 16); }
__device__ __forceinline__ float bfhi(unsigned w) { return __builtin_bit_cast(float, w & 0xffff0000u); }

#define XB_TMO      128
#define XB_XCNT(j)  (256  + 64 * (j))
#define XB_XSUB(j)  (1280 + 64 * (j))
#define XB_XGEN(j)  (2304 + 64 * (j))
#define XB_TOP      3328
#define XB_TOPGEN   3392
#define XCD_BAR_WORDS 3456
#define XB_SPIN_CAP (1u << 18)

__device__ __forceinline__ unsigned xb_ld(unsigned* p)              { return __hip_atomic_load(p, __ATOMIC_RELAXED, __HIP_MEMORY_SCOPE_AGENT); }
__device__ __forceinline__ unsigned xb_add(unsigned* p, unsigned v) { return __hip_atomic_fetch_add(p, v, __ATOMIC_RELAXED, __HIP_MEMORY_SCOPE_AGENT); }
__device__ __forceinline__ unsigned xb_xcc_id() { return (unsigned)__builtin_amdgcn_s_getreg((3 << 11) | 20) & 0xFu; }
#define XB_SPIN(cond, bar) do { unsigned _sp = 0; while (cond) { __builtin_amdgcn_s_sleep(1); \
    if ((++_sp & 255u) == 0u) { if (xb_ld(&(bar)[XB_TMO])) break; if (_sp > XB_SPIN_CAP) { atomicAdd(&(bar)[XB_TMO], 1u); break; } } } } while (0)

struct XcdBarrier {
    unsigned* bar; unsigned x; unsigned total;
    volatile LAS unsigned* st;
};

__device__ __forceinline__ XcdBarrier xcd_barrier_post(unsigned* bar, volatile LAS unsigned* st, unsigned total) {
    XcdBarrier b; b.bar = bar; b.x = xb_xcc_id(); b.st = st; b.total = total;
    if (threadIdx.x == 0) (void)xb_add(&bar[XB_XCNT(b.x)], 1u);
    return b;
}
__device__ __forceinline__ void xcd_barrier_complete(unsigned* bar, unsigned x, unsigned G, unsigned& nloc, unsigned& nx) {
    unsigned sum, cnt, mine, sp = 0u;
    for (;;) {
        sum = 0u; cnt = 0u; mine = 0u;
#pragma unroll
        for (unsigned j = 0; j < 16; ++j) { const unsigned c = xb_ld(&bar[XB_XCNT(j)]); sum += c; cnt += (c > 0u) ? 1u : 0u; }
        mine = xb_ld(&bar[XB_XCNT(x)]);
        if (sum == G) break;
        __builtin_amdgcn_s_sleep(1);
        if ((++sp & 255u) == 0u) { if (xb_ld(&bar[XB_TMO])) break; if (sp > XB_SPIN_CAP) { atomicAdd(&bar[XB_TMO], 1u); break; } }
    }
    nloc = mine > 0u ? mine : 1u; nx = cnt > 0u ? cnt : 1u;
}

__device__ __forceinline__ void xcd_barrier(const XcdBarrier& b) {
    asm volatile("s_waitcnt vmcnt(0)" ::: "memory");
    __syncthreads();
    if (threadIdx.x == 0) {
        unsigned* bar = b.bar;
        __builtin_amdgcn_s_waitcnt(0);
        unsigned nloc = b.st[0], nx = b.st[1];
        if (nloc == 0u) { xcd_barrier_complete(bar, b.x, b.total, nloc, nx); b.st[0] = nloc; b.st[1] = nx; }
        const unsigned old = xb_add(&bar[XB_XSUB(b.x)], 1u);
        const unsigned gen = old / nloc;
        if (old + 1u == (gen + 1u) * nloc) {
            __builtin_amdgcn_fence(__ATOMIC_RELEASE, "agent");
            asm volatile("s_waitcnt vmcnt(0)" ::: "memory");
            const unsigned og = xb_add(&bar[XB_TOP], 1u);
            const unsigned tg = og / nx;
            if (og + 1u == (tg + 1u) * nx) xb_add(&bar[XB_TOPGEN], 1u);
            else XB_SPIN(xb_ld(&bar[XB_TOPGEN]) == tg, bar);
            __builtin_amdgcn_fence(__ATOMIC_ACQUIRE, "agent");
            xb_add(&bar[XB_XGEN(b.x)], 1u);
            asm volatile("s_waitcnt vmcnt(0)" ::: "memory");
        } else {
            XB_SPIN(xb_ld(&bar[XB_XGEN(b.x)]) == gen, bar);
            __builtin_amdgcn_fence(__ATOMIC_ACQUIRE, "agent");
            asm volatile("s_waitcnt vmcnt(0)" ::: "memory");
        }
    }
    __syncthreads();
}


struct Frame {
    LAS unsigned char* lds;
    int tid, lane, wave;
    int vcu, G;
    int r0, mr;
    const float *xp, *xs; float* out; float* rs;
    bf16 *X, *Y, *R;
};

__device__ __forceinline__ float wave_sum(float v) {
#pragma unroll
    for (int o = 1; o < 64; o <<= 1) v += __shfl_xor(v, o);
    return v;
}
template <int MODE> __device__ __forceinline__ int map_row(int n) {
    if (MODE == 1) { if (n < 2048) return 4096 + n; const int ch = (n - 2048) & 2047; return 256 * (ch >> 7) + (n >= 4096 ? 128 : 0) + (ch & 127); }
    if (MODE == 2) { if (n >= 2560) return n; const int d = n & 127; return (n & ~127) + 2 * (d & 63) + (d >> 6); }
    if (MODE == 3) return 256 * (n >> 7) + (n & 127);
    if (MODE == 4) return 256 * (n >> 7) + 128 + (n & 127);
    return n;
}
template <int N_> __device__ __forceinline__ void p0_load(const float* W, const float* gk, int item, int lane, float (&wv)[32], float& gl) {
    constexpr int nblk = N_ / 32; const int kb = item / nblk, nb = item % nblk, k0 = 64 * kb, n0 = 32 * nb;
    gl = gk ? gk[k0 + lane] : 1.0f;
#pragma unroll
    for (int i = 0; i < 32; ++i) { const int kk = 2 * i + (lane >> 5); wv[i] = __builtin_nontemporal_load(W + (size_t)(k0 + kk) * N_ + n0 + (lane & 31)); }
}
template <int MODE, int N_> __device__ __forceinline__ void p0_store(const float (&wv)[32], float gl, int K, bf16* WT, LAS float* scr, int item, int lane) {
    constexpr int nblk = N_ / 32; const int kb = item / nblk, nb = item % nblk, k0 = 64 * kb, n0 = 32 * nb;
#pragma unroll
    for (int i = 0; i < 32; ++i) { const int kk = 2 * i + (lane >> 5); scr[kk * 33 + (lane & 31)] = wv[i] * __shfl(gl, kk); }
#if PROBE_P0_VALU
    { float dv = gl; for (int q = 0; q < PROBE_P0_VALU; ++q) { asm volatile("v_fma_f32 %0, %0, %0, %0" : "+v"(dv)); } asm volatile("" :: "v"(dv)); }
#endif
    LDS_WAIT(); asm volatile("" ::: "memory");
    const int c = lane & 7;
#pragma unroll
    for (int j = 0; j < 4; ++j) { const int n = (lane >> 3) + 8 * j; const LAS float* s = scr + (8 * c) * 33 + n;
        v4u o; o.x = pk2(s[0 * 33], s[1 * 33]); o.y = pk2(s[2 * 33], s[3 * 33]); o.z = pk2(s[4 * 33], s[5 * 33]); o.w = pk2(s[6 * 33], s[7 * 33]);
        *(GAS v4u*)(WT + (size_t)map_row<MODE>(n0 + n) * K + k0 + 8 * c) = o; }
    LDS_WAIT(); asm volatile("" ::: "memory");
}
__device__ __forceinline__ void unpack8v(const v4u& w, f32x4& a, f32x4& b) { a = (f32x4){bflo(w.x), bfhi(w.x), bflo(w.y), bfhi(w.y)}; b = (f32x4){bflo(w.z), bfhi(w.z), bflo(w.w), bfhi(w.w)}; }
__device__ __forceinline__ void norm_load(const Frame& F, int m0, int lane, v4u (&yv)[2][4], v4u (&xv)[2][4]) {
#pragma unroll
    for (int rr = 0; rr < 2; ++rr)
#pragma unroll
        for (int j = 0; j < 4; ++j) { yv[rr][j] = __builtin_nontemporal_load((const v4u*)(F.Y + (size_t)(m0 + rr) * DM + 512 * j + 8 * lane)); xv[rr][j] = __builtin_nontemporal_load((const v4u*)(F.X + (size_t)(m0 + rr) * DM + 512 * j + 8 * lane)); }
}
template <int MODE> __device__ __forceinline__ void norm_compute(const Frame& F, int m0, int lane, const v4u (&yv)[2][4], const v4u (&xv)[2][4], const f32x4 (&gp)[8], float upd) {
#pragma unroll
    for (int rr = 0; rr < 2; ++rr) {
        f32x4 yf[8], xf[8]; float ss = 0.f;
#pragma unroll
        for (int j = 0; j < 4; ++j) { unpack8v(yv[rr][j], yf[2 * j], yf[2 * j + 1]); unpack8v(xv[rr][j], xf[2 * j], xf[2 * j + 1]); }
#pragma unroll
        for (int k = 0; k < 8; ++k) ss += (yf[k][0] * yf[k][0] + yf[k][1] * yf[k][1]) + (yf[k][2] * yf[k][2] + yf[k][3] * yf[k][3]);
        const float r1 = upd / sqrtf(wave_sum(ss) * (1.0f / DM) + EPS);
#pragma unroll
        for (int k = 0; k < 8; ++k) xf[k] = xf[k] + (yf[k] * r1) * gp[k];
        if (MODE == 2) { float* xo = F.out + (size_t)(m0 + rr) * DM;
#pragma unroll
            for (int j = 0; j < 4; ++j)
#pragma unroll
                for (int q = 0; q < 2; ++q) __builtin_nontemporal_store(xf[2 * j + q], (f32x4*)(xo + 512 * j + 8 * lane + 4 * q));
        } else { float s2 = 0.f;
#pragma unroll
            for (int k = 0; k < 8; ++k) s2 += (xf[k][0] * xf[k][0] + xf[k][1] * xf[k][1]) + (xf[k][2] * xf[k][2] + xf[k][3] * xf[k][3]);
            const float r2 = 1.0f / sqrtf(wave_sum(s2) * (1.0f / DM) + EPS);
            bf16* xo = F.X + (size_t)(m0 + rr) * DM;
#pragma unroll
            for (int j = 0; j < 4; ++j) { const f32x4 a = xf[2 * j], b = xf[2 * j + 1]; v4u o; o.x = pk2(a[0], a[1]); o.y = pk2(a[2], a[3]); o.z = pk2(b[0], b[1]); o.w = pk2(b[2], b[3]); *(v4u*)(xo + 512 * j + 8 * lane) = o; }
            if (lane == 0) F.rs[m0 + rr] = r2; }
    }
}
template <int MODE> __device__ __forceinline__ void norm_phase(Frame& F, const float* gpost, const float upd = 1.0f) {
    int lane_ = F.lane; asm volatile("" : "+v"(lane_)); const int lane = lane_;
    const int gw = F.vcu * NWAVES + F.wave, NGW = F.G * NWAVES;
    f32x4 gp[8];
#pragma unroll
    for (int j = 0; j < 4; ++j)
#pragma unroll
        for (int q = 0; q < 2; ++q) gp[2 * j + q] = (MODE != 0) ? *(const f32x4*)(gpost + 512 * j + 8 * lane + 4 * q) : (f32x4){0.f, 0.f, 0.f, 0.f};
    if (MODE == 0) {
        for (int pr = gw; pr < F.mr / 2; pr += NGW) {
            const int m0 = F.r0 + 2 * pr;
            const float* xr = (m0 < MP) ? F.xp + (size_t)m0 * DM : F.xs + (size_t)(m0 - MP) * DM;
            f32x4 x[2][8];
#pragma unroll
            for (int rr = 0; rr < 2; ++rr)
#pragma unroll
                for (int j = 0; j < 4; ++j)
#pragma unroll
                    for (int q = 0; q < 2; ++q) x[rr][2 * j + q] = __builtin_nontemporal_load((const f32x4*)(xr + (size_t)rr * DM + 512 * j + 8 * lane + 4 * q));
#pragma unroll
            for (int rr = 0; rr < 2; ++rr) { float s2 = 0.f;
#pragma unroll
                for (int k = 0; k < 8; ++k) s2 += (x[rr][k][0] * x[rr][k][0] + x[rr][k][1] * x[rr][k][1]) + (x[rr][k][2] * x[rr][k][2] + x[rr][k][3] * x[rr][k][3]);
                const float r2 = 1.0f / sqrtf(wave_sum(s2) * (1.0f / DM) + EPS);
                bf16* xo = F.X + (size_t)(m0 + rr) * DM;
#pragma unroll
                for (int j = 0; j < 4; ++j) { const f32x4 a = x[rr][2 * j], b = x[rr][2 * j + 1]; v4u o; o.x = pk2(a[0], a[1]); o.y = pk2(a[2], a[3]); o.z = pk2(b[0], b[1]); o.w = pk2(b[2], b[3]); *(v4u*)(xo + 512 * j + 8 * lane) = o; }
                if (lane == 0) F.rs[m0 + rr] = r2; }
        }
    } else {
        for (int pr = gw; pr < F.mr / 2; pr += NGW) { v4u ya[2][4], xa[2][4]; norm_load(F, F.r0 + 2 * pr, lane, ya, xa); norm_compute<MODE>(F, F.r0 + 2 * pr, lane, ya, xa, gp, upd); }
    }
}
__device__ __forceinline__ void unpack8(const v4u& w, float (&f)[8]) { f[0] = bflo(w.x); f[1] = bfhi(w.x); f[2] = bflo(w.y); f[3] = bfhi(w.y); f[4] = bflo(w.z); f[5] = bfhi(w.z); f[6] = bflo(w.w); f[7] = bfhi(w.w); }
__device__ __forceinline__ void conv_phase(Frame& F, bf16* Bb, const bf16* U, const float* wdw) {
    int lane_ = F.lane; asm volatile("" : "+v"(lane_)); const int lane = lane_;
    const int gw = F.vcu * NWAVES + F.wave, NGW = F.G * NWAVES;
    constexpr int RUN = 32; const int NTASK = (F.mr / RUN) * 4;
    for (int t = gw; t < NTASK; t += NGW) {
        const int cc = t & 3, row0 = (t >> 2) * RUN,
                  col = 512 * cc + 8 * lane, s0 = row0 & (SEQ - 1);
        float w0[8], w1[8], w2[8];
#pragma unroll
        for (int q = 0; q < 2; ++q) { const f32x4 a = *(const f32x4*)(wdw + col + 4 * q), b = *(const f32x4*)(wdw + DM + col + 4 * q), c = *(const f32x4*)(wdw + 2 * DM + col + 4 * q);
#pragma unroll
            for (int e = 0; e < 4; ++e) { w0[4 * q + e] = a[e]; w1[4 * q + e] = b[e]; w2[4 * q + e] = c[e]; } }
        const bf16* up = U + (size_t)row0 * DM + col; bf16* bp = Bb + (size_t)row0 * DM + col;
        float uprev[8], ucur[8];
        { const v4u a = *(const v4u*)(s0 == 0 ? up : up - DM), b = *(const v4u*)up; unpack8(a, uprev); unpack8(b, ucur);
          if (s0 == 0) {
#pragma unroll
              for (int e = 0; e < 8; ++e) uprev[e] = 0.f; } }
#pragma unroll 1
        for (int g = 0; g < RUN; g += 8) {
            v4u un[8], bb[8];
#pragma unroll
            for (int i = 0; i < 8; ++i) { const int rr = g + i; const bool last = (s0 + rr == SEQ - 1); un[i] = *(const v4u*)(up + (size_t)(last ? rr : rr + 1) * DM); bb[i] = __builtin_nontemporal_load((const v4u*)(bp + (size_t)rr * DM)); }
#pragma unroll
            for (int i = 0; i < 8; ++i) { const int rr = g + i; const bool last = (s0 + rr == SEQ - 1);
                float unx[8], bf[8]; unpack8(un[i], unx); unpack8(bb[i], bf);
                if (last) {
#pragma unroll
                    for (int e = 0; e < 8; ++e) unx[e] = 0.f; }
                float o[8];
#pragma unroll
                for (int e = 0; e < 8; ++e) { o[e] = bf[e] * (w0[e] * uprev[e] + w1[e] * ucur[e] + w2[e] * unx[e]); uprev[e] = ucur[e]; ucur[e] = unx[e]; }
                v4u w; w.x = pk2(o[0], o[1]); w.y = pk2(o[2], o[3]); w.z = pk2(o[4], o[5]); w.w = pk2(o[6], o[7]);
                *(v4u*)(bp + (size_t)rr * DM) = w; }
        }
    }
}
__device__ __forceinline__ void convert_layer(Frame& F, const float* const* in, unsigned char* ws, unsigned char* ob, int L) {
    int lane_ = F.lane; asm volatile("" : "+v"(lane_)); const int lane = lane_;
    LAS float* scr = (LAS float*)(F.lds + RING_OFF + F.wave * 16384);
    const int gw = F.vcu * NWAVES + F.wave, NGW = F.G * NWAVES;
    constexpr int I_WIN = (DM / 64) * (3 * DM / 32), I_SQ = (DM / 64) * (DM / 32), I_QKV = (DM / 64) * (NQKV / 32), I_GU = (DM / 64) * (FF / 32), I_D = (FF / 64) * (DM / 32);
    const int j = L >> 1; const bool att = (L & 1) != 0;
    const int NITEMS = (att ? I_QKV : I_WIN) + I_SQ + 2 * I_GU + I_D;
#define P0_FOR_ITEM(it_, OP) do { int r = (it_); \
        if (!att) { if (r < I_WIN) { OP(1, 3 * DM, DM, in[2] + (size_t)j * DM * 3 * DM, in[11] + (2 * j) * DM, (bf16*)(ws + WS_WIN + j * SZ_WIN), r); break; } r -= I_WIN; \
                    if (r < I_SQ) { OP(0, DM, DM, in[4] + (size_t)j * DM * DM, (const float*)nullptr, (bf16*)(ws + WS_WOUT + j * SZ_WSQ), r); break; } r -= I_SQ; } \
        else      { if (r < I_QKV) { OP(2, NQKV, DM, in[5] + (size_t)j * DM * NQKV, in[11] + (2 * j + 1) * DM, (bf16*)(ws + WS_WQKV + j * SZ_WQKV), r); break; } r -= I_QKV; \
                    if (r < I_SQ) { OP(0, DM, DM, in[6] + (size_t)j * DM * DM, (const float*)nullptr, (bf16*)(ws + WS_WO + j * SZ_WSQ), r); break; } r -= I_SQ; } \
        if (r < I_GU) { OP(3, FF, DM, in[8] + (size_t)L * DM * FF, in[13] + L * DM, (bf16*)(ob + OUT_WGU + L * SZ_WGU), r); break; } r -= I_GU; \
        if (r < I_GU) { OP(4, FF, DM, in[9] + (size_t)L * DM * FF, in[13] + L * DM, (bf16*)(ob + OUT_WGU + L * SZ_WGU), r); break; } r -= I_GU; \
        OP(0, DM, FF, in[10] + (size_t)L * FF * DM, (const float*)nullptr, (bf16*)(ob + OUT_WD + L * SZ_WD), r); } while (0)
#define P0_OP_LOAD(MODE, N_, K_, W_, G_, D_, LI_) p0_load<N_>(W_, G_, LI_, lane, wnext, glnext)
#define P0_OP_STORE(MODE, N_, K_, W_, G_, D_, LI_) p0_store<MODE, N_>(wcur, glcur, K_, D_, scr, LI_, lane)
    float wcur[32], wnext[32], glcur = 1.0f, glnext = 1.0f;
    if (gw < NITEMS) { P0_FOR_ITEM(gw, P0_OP_LOAD); }
    for (int it = gw; it < NITEMS; it += NGW) {
#pragma unroll
        for (int i = 0; i < 32; ++i) wcur[i] = wnext[i];
        glcur = glnext;
        if (it + NGW < NITEMS) { P0_FOR_ITEM(it + NGW, P0_OP_LOAD); }
        P0_FOR_ITEM(it, P0_OP_STORE);
    }
#undef P0_FOR_ITEM
#undef P0_OP_LOAD
#undef P0_OP_STORE
}
__device__ __forceinline__ void p0_prologue(Frame& F, const float* const* in, unsigned char* ws, unsigned char* ob) {
    const int gw = F.vcu * NWAVES + F.wave, NGW = F.G * NWAVES;
    convert_layer(F, in, ws, ob, 0);
    { const int gt = gw * 64 + F.lane, NGT = NGW * 64; f32x4* tab = (f32x4*)(ws + WS_ROPE);
      for (int e = gt; e < SEQ * 32; e += NGT) { const int pos = e >> 5, i0 = (e & 31) * 2; float cs[4];
#pragma unroll
          for (int q = 0; q < 2; ++q) { double pw = 1.0; for (int k = 0; k < i0 + q; ++k) pw *= 1.1547819846894583;
              const float invf = 1.0f / (float)pw; const float ang = (float)pos * invf;
              const double turns = (double)ang * 0.15915494309189535; const float fr = (float)(turns - __builtin_rint(turns));
              cs[2 * q] = __builtin_amdgcn_cosf(fr); cs[2 * q + 1] = __builtin_amdgcn_sinf(fr); }
          tab[e] = (f32x4){cs[0], cs[1], cs[2], cs[3]}; } }
    norm_phase<0>(F, nullptr);
}

struct Args { const float* in[15]; float* out; unsigned char* ws; };
__global__ void __launch_bounds__(NWAVES * 64, 2) fwd_kernel(Args args) {
    extern __shared__ __attribute__((aligned(16))) unsigned char lds[];
    Frame F;
    F.lds = (LAS unsigned char*)lds;
    volatile LAS unsigned* MISC = (volatile LAS unsigned*)(F.lds + MISC_OFF);
    F.tid = threadIdx.x; F.lane = F.tid & 63; F.wave = __builtin_amdgcn_readfirstlane(F.tid >> 6);
    const int Gall = gridDim.x, bx = blockIdx.x;
    const int vcu_all = (Gall % 8 == 0) ? (bx % 8) * (Gall / 8) + bx / 8 : bx;
    const bool two = TWO_GROUPS && (Gall % 8 == 0);
    const int grp = two ? ((bx % 8) >> 2) : 0;
    const int GG = two ? Gall / 2 : Gall, nx = two ? 4 : 8;
    const int c_loc = two ? (bx / 8) * 4 + (bx % 4) : bx;
    const int vcu_loc = two ? (bx % 4) * (GG / 4) + bx / 8 : vcu_all;
    const int r0g = two ? grp * (M / 2) : 0, mrg = two ? M / 2 : M;
    unsigned char* ws = args.ws;
    gu32* ctl = (gu32*)(ws + WS_CTL);
    F.xp = args.in[0]; F.xs = args.in[1]; F.out = args.out; F.rs = (float*)(ws + WS_RS); F.X = (bf16*)(ws + WS_X); F.Y = (bf16*)(ws + WS_Y); F.R = (bf16*)(ws + WS_R);
    unsigned char* const ob = (unsigned char*)args.out;
    for (int u = F.tid; u < (LDS_BYTES - LDSCTL_OFF) / 4; u += NWAVES * 64) ((LAS unsigned*)(F.lds + LDSCTL_OFF))[u] = 0u;
    __syncthreads();
    const XcdBarrier barAll = xcd_barrier_post((unsigned*)(ctl + CW_BAR), MISC + 8, (unsigned)Gall);
    const XcdBarrier barG = xcd_barrier_post((unsigned*)(ctl + CW_BAR) + (1 + grp) * XCD_BAR_WORDS, MISC + 10, (unsigned)GG);
    const size_t r0 = (size_t)r0g;
    bf16* const Rg = F.R + (size_t)r0g * FF;
    bf16* const Rq = Rg;
    bf16* const Rc = Rg + (size_t)mrg * DM;
    bf16* const Rk = Rc; bf16* const Rv = Rc + (size_t)mrg * 512; bf16* const Ro = Rc + (size_t)mrg * 1024;

    F.vcu = vcu_all; F.G = Gall; F.r0 = 0; F.mr = M;
    p0_prologue(F, args.in, ws, ob);
    if (!two) { for (int L = 1; L < DEPTH; ++L) convert_layer(F, args.in, ws, ob, L); }
    xcd_barrier(barAll);
    F.vcu = vcu_loc; F.G = GG; F.r0 = r0g; F.mr = mrg;
    if (two && grp == 1) {
        convert_layer(F, args.in, ws, ob, 1); convert_layer(F, args.in, ws, ob, 2);
        xcd_barrier(barG);
        if (vcu_loc == 0 && F.tid == 0) { __hip_atomic_store(ctl + CW_FLAG + 64 * 1, 1u, RLX_AGENT); __hip_atomic_store(ctl + CW_FLAG + 64 * 2, 1u, RLX_AGENT); }
    }

    for (int li = 0; li < DEPTH; ++li) {
        const int j = li >> 1;
        const bool is_attn = (li & 1) != 0;
        if (two && li >= 1 && grp == (li == 3 ? 1 : 0)) {
            if (F.tid == 0) { unsigned sp = 0; while (__hip_atomic_load(ctl + CW_FLAG + 64 * li, RLX_AGENT) == 0u) { __builtin_amdgcn_s_sleep(8); if (++sp > (1u << 22)) break; }
                __builtin_amdgcn_fence(__ATOMIC_ACQUIRE, "agent"); asm volatile("s_waitcnt vmcnt(0)" ::: "memory"); }
            __syncthreads();
        }
        if (!is_attn) {
            pg8::Gemm g{F.X + r0 * DM, (const bf16*)(ws + WS_WIN + j * SZ_WIN), mrg, 3 * DM, DM}; pg8::StaticOrder S; S.init(mrg, 3 * DM, GG, c_loc, nx);
            pg8::EpiConvIn E{Rc, Rq, F.rs + r0};
            pg8::gemm_phase<pg8::EpiConvIn, pg8::StaticOrder, true, true>(F.lds + RING_OFF, g, S, E);
        } else {
            pg8::Gemm g{F.X + r0 * DM, (const bf16*)(ws + WS_WQKV + j * SZ_WQKV), mrg, NQKV, DM}; pg8::StaticOrder S; S.init(mrg, NQKV, GG, c_loc, nx);
            pg8::EpiQKV E{Rq, (size_t)(Rk - Rq), (size_t)(Rv - Rq), (const pg8::f32x4*)(ws + WS_ROPE), F.rs + r0, 0.12751743082459868f};
            pg8::gemm_phase<pg8::EpiQKV, pg8::StaticOrder, true, true>(F.lds + RING_OFF, g, S, E);
        }
        xcd_barrier(barG);
        if (!is_attn) conv_phase(F, Rq, Rc, args.in[3] + (size_t)j * 3 * DM);
        else { const int nun = (mrg / SEQ) * 128; for (int a = vcu_loc; a < nun; a += GG) attn::attn_unit(a >> 7, (a >> 5) & 3, a & 31, Rq, Ro, Rk, Rv, args.in[7] + j * 16, F.lds + RING_OFF); }
        xcd_barrier(barG);
        {
            pg8::Gemm g{is_attn ? Ro : Rq, (const bf16*)(is_attn ? ws + WS_WO + j * SZ_WSQ : ws + WS_WOUT + j * SZ_WSQ), mrg, DM, DM}; pg8::StaticOrder S; S.init(mrg, DM, GG, c_loc, nx);
            pg8::EpiPlain E{F.Y + r0 * DM, DM};
            pg8::gemm_phase<pg8::EpiPlain, pg8::StaticOrder, true, true>(F.lds + RING_OFF, g, S, E);
        }
        xcd_barrier(barG);
        norm_phase<1>(F, args.in[12] + li * DM);
        xcd_barrier(barG);
        {
            pg8::Gemm g{F.X + r0 * DM, (const bf16*)(ob + OUT_WGU + li * SZ_WGU), mrg, 2 * FF, DM}; pg8::StaticOrder S; S.init(mrg, 2 * FF, GG, c_loc, nx);
            pg8::EpiSwiGLU E{Rg, FF, F.rs + r0};
            pg8::gemm_phase<pg8::EpiSwiGLU, pg8::StaticOrder, true, true>(F.lds + RING_OFF, g, S, E);
        }
        xcd_barrier(barG);
        {
            pg8::Gemm g{Rg, (const bf16*)(ob + OUT_WD + li * SZ_WD), mrg, DM, FF}; pg8::StaticOrder S; S.init(mrg, DM, GG, c_loc, nx);
            pg8::EpiPlain E{F.Y + r0 * DM, DM};
            pg8::gemm_phase<pg8::EpiPlain, pg8::StaticOrder, true, true>(F.lds + RING_OFF, g, S, E);
        }
        if (li + 1 < DEPTH) { xcd_barrier(barG); norm_phase<1>(F, args.in[14] + li * DM);
            const bool cv = two && grp == 0 && li == 0;
            if (cv) convert_layer(F, args.in, ws, ob, 3);
            xcd_barrier(barG);
            if (cv && vcu_loc == 0 && F.tid == 0) __hip_atomic_store(ctl + CW_FLAG + 64 * 3, 1u, RLX_AGENT); }
        else { xcd_barrier(barAll); norm_phase<2>(F, args.in[14] + li * DM); }
    }
}

extern "C" void kernel_launch(void* const* d_in, const int* in_sizes, int n_in, void* d_out, int out_size, void* d_ws, size_t ws_size, hipStream_t stream) {
    static int grid = 0;
    if (grid == 0) {
        if (n_in != 15 || out_size != M * DM || ws_size < WS_END) { fprintf(stderr, "kernel_launch: unexpected shapes (n_in %d, out %d, ws %zu < %zu); nothing launched\n", n_in, out_size, ws_size, (size_t)WS_END); grid = -1; return; }
        int dev = 0, cus = 0, per_cu = 0;
        if (hipGetDevice(&dev) != hipSuccess || hipDeviceGetAttribute(&cus, hipDeviceAttributeMultiprocessorCount, dev) != hipSuccess) { grid = -1; return; }
        if (hipFuncSetAttribute((const void*)fwd_kernel, hipFuncAttributeMaxDynamicSharedMemorySize, LDS_BYTES) != hipSuccess) { fprintf(stderr, "kernel_launch: hipFuncSetAttribute failed\n"); grid = -1; return; }
        if (hipOccupancyMaxActiveBlocksPerMultiprocessor(&per_cu, (const void*)fwd_kernel, NWAVES * 64, LDS_BYTES) != hipSuccess || per_cu < 1) { fprintf(stderr, "kernel_launch: occupancy query says %d blocks per CU\n", per_cu); }
        (void)hipGetLastError();
        grid = cus;
    }
    if (grid < 0) return;
    if (hipMemsetAsync((char*)d_ws + WS_CTL, 0, CTL_ZERO_BYTES, stream) != hipSuccess) return;
    Args a{};
    for (int i = 0; i < 15; ++i) a.in[i] = (const float*)d_in[i];
    a.out = (float*)d_out; a.ws = (unsigned char*)d_ws;
    hipLaunchKernelGGL(fwd_kernel, dim3(grid), dim3(NWAVES * 64), LDS_BYTES, stream, a);
}
```
